# Optimizing an MI355X kernel written in HIP

```python
import jax, jax.numpy as jnp
from jax import lax
import numpy as np

D_MODEL = 1024
BATCH = 32
SEQ = 2048
DEPTH = 2
DEC_BATCH = 32
DEC_SEQ = 32
PAST_LEN = 4096

CHUNK = 64
N_A_LAYERS = DEPTH // 2
N_B_LAYERS = DEPTH - N_A_LAYERS
PLE_DIM = 256
D_FF = 2816
NORM_EPS = 1e-6
SSM_EXPAND = 2
D_INNER = SSM_EXPAND * D_MODEL
SSM_HEAD_DIM = 64
SSM_HEADS = D_INNER // SSM_HEAD_DIM
SSM_GROUPS = 4
SSM_HEADS_PER_GROUP = SSM_HEADS // SSM_GROUPS
D_STATE = 128
CONV_W = 4
CONV_DIM = D_INNER + 2 * SSM_GROUPS * D_STATE
IN_DIM = D_INNER + CONV_DIM + SSM_HEADS
SSD_CHUNK = CHUNK
SB_HEAD_DIM = 64
SB_HEADS = D_MODEL // SB_HEAD_DIM
SB_KV_HEADS = 4
SB_Q_PER_KV = SB_HEADS // SB_KV_HEADS
Q_BLOCK = 128

kernel_name = "yoco_mamba2_stickbreak_stream_step"


def rms_norm(x, g):
    xf = x.astype(jnp.float32)
    y = xf * lax.rsqrt(jnp.mean(xf * xf, axis=-1, keepdims=True) + NORM_EPS)
    return (y * g.astype(jnp.float32)).astype(x.dtype)


def swiglu(h, w_gate, w_up, w_down):
    return (jax.nn.silu(h @ w_gate) * (h @ w_up)) @ w_down


def causal_dwconv(u, buf, w, b):
    L = u.shape[1]
    upad = jnp.concatenate([buf.astype(u.dtype), u], axis=1)
    out = b + upad[:, 0:L] * w[0]
    for k in range(1, CONV_W):
        out = out + upad[:, k:k + L] * w[k]
    return out, upad[:, -(CONV_W - 1):]


def ssd_scan(xdt, a, Bm, Cm, s0, chunk_len):
    b, L, G, E, P = xdt.shape
    nc = L // chunk_len

    def to_chunks(t):
        return jnp.moveaxis(t.reshape((b, nc, chunk_len) + t.shape[2:]), 1, 0)

    causal = jnp.tril(jnp.ones((chunk_len, chunk_len), dtype=bool))[None, :, :, None, None]

    def step(state, inp):
        x_c, a_c, B_c, C_c = inp
        a_cs = jnp.cumsum(a_c, axis=1)
        seg = a_cs[:, :, None] - a_cs[:, None, :]
        decay = jnp.exp(jnp.where(causal, seg, -jnp.inf))
        cb = jnp.einsum('bign,bjgn->bijg', C_c, B_c)
        y_diag = jnp.einsum('bijg,bijge,bjgep->bigep', cb, decay, x_c)
        y_off = jnp.einsum('bign,bgepn->bigep', C_c, state) * jnp.exp(a_cs)[..., None]
        w_end = jnp.exp(a_cs[:, -1:] - a_cs)
        new_state = state * jnp.exp(a_cs[:, -1])[..., None, None] + jnp.einsum(
            'bjgn,bjge,bjgep->bgepn', B_c, w_end, x_c)
        return new_state, y_diag + y_off

    s_fin, ys = lax.scan(step, s0, (to_chunks(xdt), to_chunks(a), to_chunks(Bm), to_chunks(Cm)))
    y = jnp.moveaxis(ys, 0, 1).reshape(b, L, G, E, P)
    return y, s_fin


def mamba2_mixer(h, ssm0, conv0, w_in, conv_w, conv_b, dt_bias, a_log, d_skip, norm_g, w_out):
    b, L, _ = h.shape
    zxbcdt = h @ w_in
    z = zxbcdt[..., :D_INNER]
    xbc = zxbcdt[..., D_INNER:D_INNER + CONV_DIM]
    dt_raw = zxbcdt[..., D_INNER + CONV_DIM:]
    xbc, conv_new = causal_dwconv(xbc, conv0, conv_w, conv_b)
    xbc = jax.nn.silu(xbc).astype(jnp.float32)
    xs = xbc[..., :D_INNER].reshape(b, L, SSM_GROUPS, SSM_HEADS_PER_GROUP, SSM_HEAD_DIM)
    Bm = xbc[..., D_INNER:D_INNER + SSM_GROUPS * D_STATE].reshape(b, L, SSM_GROUPS, D_STATE)
    Cm = xbc[..., D_INNER + SSM_GROUPS * D_STATE:].reshape(b, L, SSM_GROUPS, D_STATE)
    dt = jax.nn.softplus(dt_raw.astype(jnp.float32) + dt_bias.astype(jnp.float32))
    dt = dt.reshape(b, L, SSM_GROUPS, SSM_HEADS_PER_GROUP)
    A = -jnp.exp(a_log.astype(jnp.float32)).reshape(SSM_GROUPS, SSM_HEADS_PER_GROUP)
    s0 = ssm0.astype(jnp.float32).reshape(b, SSM_GROUPS, SSM_HEADS_PER_GROUP, SSM_HEAD_DIM, D_STATE)
    chunk_len = min(SSD_CHUNK, L)
    y, s_fin = ssd_scan(xs * dt[..., None], dt * A, Bm, Cm, s0, chunk_len)
    y = y + xs * d_skip.astype(jnp.float32).reshape(SSM_GROUPS, SSM_HEADS_PER_GROUP)[..., None]
    y = y.reshape(b, L, D_INNER) * jax.nn.silu(z.astype(jnp.float32))
    yg = y.reshape(b, L, SSM_GROUPS, D_INNER // SSM_GROUPS)
    yg = yg * lax.rsqrt(jnp.mean(yg * yg, axis=-1, keepdims=True) + NORM_EPS)
    y = yg.reshape(b, L, D_INNER) * norm_g.astype(jnp.float32)
    out = y.astype(h.dtype) @ w_out
    s_fin = s_fin.reshape(b, SSM_HEADS, SSM_HEAD_DIM, D_STATE).astype(ssm0.dtype)
    return out, s_fin, conv_new.astype(conv0.dtype)


def sb_block(q, k, v, q0):
    lq, lk = q.shape[1], k.shape[1]
    z = jnp.einsum('bqhgd,bkhd->bhgqk', q.astype(jnp.float32), k.astype(jnp.float32)) * (SB_HEAD_DIM ** -0.5)
    q_pos = q0 + jnp.arange(lq)
    mask = jnp.arange(lk)[None, :] < q_pos[:, None]
    log_1m_beta = jnp.where(mask, jax.nn.log_sigmoid(-z), 0.0)
    log_a = z + lax.cumsum(log_1m_beta, axis=4, reverse=True)
    a = jnp.exp(jnp.where(mask, log_a, -jnp.inf))
    out = jnp.einsum('bhgqk,bkhd->bqhgd', a, v.astype(jnp.float32))
    return out.astype(q.dtype)


def sb_attention(q, k, v, q_start):
    lq = q.shape[1]
    blk = min(Q_BLOCK, lq)
    outs = []
    for s0 in range(0, lq, blk):
        e = min(s0 + blk, lq)
        n_keys = q_start + e
        outs.append(sb_block(q[:, s0:e], k[:, :n_keys], v[:, :n_keys], q_start + s0))
    return jnp.concatenate(outs, axis=1)


def trunk(x, p, ssm0, conv0, k_past, v_past, q_start,
          ffn_norm, ffn_w_gate, ffn_w_up, ffn_w_down, mix_norm,
          ssm_w_in, ssm_conv_w, ssm_conv_b, ssm_dt_bias, ssm_a_log, ssm_d, ssm_norm, ssm_w_out,
          kv_norm, w_k, w_v, sb_w_q, sb_w_o,
          ple_norm, ple_w_gate, ple_w_proj, final_norm):
    b, L, _ = x.shape
    ssm_out, conv_out = [], []
    k_new = v_new = k_all = v_all = None
    for i in range(DEPTH):
        if i == N_A_LAYERS:
            kv_in = rms_norm(x, kv_norm)
            k_new = (kv_in @ w_k).reshape(b, L, SB_KV_HEADS, SB_HEAD_DIM)
            v_new = (kv_in @ w_v).reshape(b, L, SB_KV_HEADS, SB_HEAD_DIM)
            if k_past is None:
                k_all, v_all = k_new, v_new
            else:
                k_all = jnp.concatenate([k_past.astype(k_new.dtype), k_new], axis=1)
                v_all = jnp.concatenate([v_past.astype(v_new.dtype), v_new], axis=1)
        x = x + 0.5 * swiglu(rms_norm(x, ffn_norm[i, 0]), ffn_w_gate[i, 0], ffn_w_up[i, 0], ffn_w_down[i, 0])
        h = rms_norm(x, mix_norm[i])
        if i < N_A_LAYERS:
            mix, s_fin, c_fin = mamba2_mixer(h, ssm0[i], conv0[i], ssm_w_in[i], ssm_conv_w[i], ssm_conv_b[i],
                                             ssm_dt_bias[i], ssm_a_log[i], ssm_d[i], ssm_norm[i], ssm_w_out[i])
            ssm_out.append(s_fin)
            conv_out.append(c_fin)
        else:
            j = i - N_A_LAYERS
            q = (h @ sb_w_q[j]).reshape(b, L, SB_KV_HEADS, SB_Q_PER_KV, SB_HEAD_DIM)
            o = sb_attention(q, k_all, v_all, q_start)
            mix = o.reshape(b, L, SB_HEADS * SB_HEAD_DIM) @ sb_w_o[j]
        x = x + mix
        x = x + 0.5 * swiglu(rms_norm(x, ffn_norm[i, 1]), ffn_w_gate[i, 1], ffn_w_up[i, 1], ffn_w_down[i, 1])
        gate = jax.nn.sigmoid(rms_norm(x, ple_norm[i]) @ ple_w_gate[i])
        x = x + gate * (p[i] @ ple_w_proj[i])
    return rms_norm(x, final_norm), jnp.stack(ssm_out), jnp.stack(conv_out), k_new, v_new


def setup_inputs(seed: int = 0) -> dict:
    key = jax.random.key(seed)
    ks = jax.random.split(key, 40)

    def nrm(k, shape, scale):
        return jax.random.normal(k, shape, jnp.float32) * scale

    NA, NB = N_A_LAYERS, N_B_LAYERS
    dt0 = jnp.exp(jax.random.uniform(ks[20], (NA, SSM_HEADS), jnp.float32,
                                     minval=float(np.log(1e-3)), maxval=float(np.log(1e-1))))
    return {
        "x_prompt": nrm(ks[0], (BATCH, SEQ, D_MODEL), 1.0),
        "x_sample": nrm(ks[1], (DEC_BATCH, DEC_SEQ, D_MODEL), 1.0),
        "p_prompt": nrm(ks[2], (DEPTH, BATCH, SEQ, PLE_DIM), 1.0),
        "p_sample": nrm(ks[3], (DEPTH, DEC_BATCH, DEC_SEQ, PLE_DIM), 1.0),
        "state_ssm": nrm(ks[4], (NA, DEC_BATCH, SSM_HEADS, SSM_HEAD_DIM, D_STATE), 0.5),
        "state_conv": nrm(ks[5], (NA, DEC_BATCH, CONV_W - 1, CONV_DIM), 1.0),
        "cache_k": nrm(ks[6], (DEC_BATCH, PAST_LEN, SB_KV_HEADS, SB_HEAD_DIM), 1.0),
        "cache_v": nrm(ks[7], (DEC_BATCH, PAST_LEN, SB_KV_HEADS, SB_HEAD_DIM), 1.0),
        "ffn_norm": 1.0 + nrm(ks[8], (DEPTH, 2, D_MODEL), 0.05),
        "ffn_w_gate": nrm(ks[9], (DEPTH, 2, D_MODEL, D_FF), D_MODEL ** -0.5),
        "ffn_w_up": nrm(ks[10], (DEPTH, 2, D_MODEL, D_FF), D_MODEL ** -0.5),
        "ffn_w_down": nrm(ks[11], (DEPTH, 2, D_FF, D_MODEL), D_FF ** -0.5),
        "mix_norm": 1.0 + nrm(ks[12], (DEPTH, D_MODEL), 0.05),
        "ssm_w_in": nrm(ks[13], (NA, D_MODEL, IN_DIM), D_MODEL ** -0.5),
        "ssm_conv_w": nrm(ks[14], (NA, CONV_W, CONV_DIM), CONV_W ** -0.5),
        "ssm_conv_b": nrm(ks[15], (NA, CONV_DIM), 0.01),
        "ssm_dt_bias": dt0 + jnp.log(-jnp.expm1(-dt0)),
        "ssm_a_log": jnp.log(jax.random.uniform(ks[16], (NA, SSM_HEADS), jnp.float32, minval=1.0, maxval=16.0)),
        "ssm_d": 1.0 + nrm(ks[17], (NA, SSM_HEADS), 0.1),
        "ssm_norm": 1.0 + nrm(ks[18], (NA, D_INNER), 0.05),
        "ssm_w_out": nrm(ks[19], (NA, D_INNER, D_MODEL), D_INNER ** -0.5),
        "kv_norm": 1.0 + nrm(ks[21], (D_MODEL,), 0.05),
        "w_k": nrm(ks[22], (D_MODEL, SB_KV_HEADS * SB_HEAD_DIM), D_MODEL ** -0.5),
        "w_v": nrm(ks[23], (D_MODEL, SB_KV_HEADS * SB_HEAD_DIM), D_MODEL ** -0.5),
        "sb_w_q": nrm(ks[24], (NB, D_MODEL, SB_HEADS * SB_HEAD_DIM), D_MODEL ** -0.5),
        "sb_w_o": nrm(ks[25], (NB, SB_HEADS * SB_HEAD_DIM, D_MODEL), (SB_HEADS * SB_HEAD_DIM) ** -0.5),
        "ple_norm": 1.0 + nrm(ks[26], (DEPTH, D_MODEL), 0.05),
        "ple_w_gate": nrm(ks[27], (DEPTH, D_MODEL, D_MODEL), D_MODEL ** -0.5),
        "ple_w_proj": nrm(ks[28], (DEPTH, PLE_DIM, D_MODEL), PLE_DIM ** -0.5),
        "final_norm": 1.0 + nrm(ks[29], (D_MODEL,), 0.05),
    }


def reference(x_prompt, x_sample, p_prompt, p_sample, state_ssm, state_conv, cache_k, cache_v,
              ffn_norm, ffn_w_gate, ffn_w_up, ffn_w_down, mix_norm,
              ssm_w_in, ssm_conv_w, ssm_conv_b, ssm_dt_bias, ssm_a_log, ssm_d, ssm_norm, ssm_w_out,
              kv_norm, w_k, w_v, sb_w_q, sb_w_o,
              ple_norm, ple_w_gate, ple_w_proj, final_norm):
    weights = (ffn_norm, ffn_w_gate, ffn_w_up, ffn_w_down, mix_norm,
               ssm_w_in, ssm_conv_w, ssm_conv_b, ssm_dt_bias, ssm_a_log, ssm_d, ssm_norm, ssm_w_out,
               kv_norm, w_k, w_v, sb_w_q, sb_w_o,
               ple_norm, ple_w_gate, ple_w_proj, final_norm)
    bp = x_prompt.shape[0]
    ssm0_p = jnp.zeros((N_A_LAYERS, bp, SSM_HEADS, SSM_HEAD_DIM, D_STATE), state_ssm.dtype)
    conv0_p = jnp.zeros((N_A_LAYERS, bp, CONV_W - 1, CONV_DIM), state_conv.dtype)
    y_prompt, ssm_p, conv_p, k_p, v_p = trunk(x_prompt, p_prompt, ssm0_p, conv0_p, None, None, 0, *weights)
    y_sample, ssm_s, conv_s, k_s, v_s = trunk(x_sample, p_sample, state_ssm, state_conv, cache_k, cache_v,
                                              cache_k.shape[1], *weights)
    return (y_prompt, y_sample, ssm_p, conv_p, k_p, v_p, ssm_s, conv_s, k_s, v_s)
```

```cpp
#include <hip/hip_runtime.h>
#include <hip/hip_cooperative_groups.h>
#include <cstdio>
#include <cstdint>
namespace cg = cooperative_groups;

#ifndef MK_MULTI
#define MK_MULTI 0
#endif

constexpr int DM = 1024, MP = 65536, MS = 1024, MA = MP + MS;
constexpr int DFF = 2816, DIN = 2048, CONVD = 3072, NIN = 5376;
constexpr int SEQ = 2048, DSEQ = 32, PAST = 4096;
constexpr float EPS = 1e-6f;
constexpr size_t OFF_Y = 0, OFF_SSM_P = 68157440, OFF_CONV_P = 76546048, OFF_K_P = 76840960, OFF_V_P = 93618176,
                 OFF_SSM_S = 110395392, OFF_CONV_S = 118784000, OFF_K_S = 119078912, OFF_V_S = 119341056;
constexpr size_t MiB = 1u << 20;
constexpr size_t WS_ST = 0;
constexpr size_t WS_CNT = 3 * MiB;
constexpr size_t WS_WT = 4 * MiB;
constexpr size_t WS_XB = 100 * MiB;
constexpr size_t WS_PB = 230 * MiB;
constexpr size_t WS_R = 295 * MiB;
constexpr size_t R_ACT = WS_R, R_Z = WS_R, R_XBC = WS_R + 260 * MiB, R_QO = WS_R + 358 * MiB,
                 R_KP = WS_R + 488 * MiB, R_VP = WS_R + 520 * MiB, R_KSN = WS_R + 552 * MiB, R_VSN = WS_R + 553 * MiB;
constexpr size_t WS_DT = 945 * MiB;
constexpr size_t WS_END = 956 * MiB;
constexpr size_t O_GU00 = 0, O_GU01 = 5767168, O_KV = 11534336, O_GU10 = 12058624, O_GU11 = 17825792, O_D = 23592960,
                 O_IN = 35127296, O_OUT = 40632320, O_Q = 42729472, O_O = 43778048, O_PG0 = 44826624, O_PG1 = 45875200,
                 O_PP0 = 46923776, O_PP1 = 47185920;
constexpr size_t D_STRIDE = 2883584;

#define LAS __attribute__((address_space(3)))
typedef unsigned short bf16_t;
typedef short bf16x8 __attribute__((ext_vector_type(8)));
typedef short s16x4 __attribute__((ext_vector_type(4)));
typedef float f32x4 __attribute__((ext_vector_type(4)));
typedef float f32x16 __attribute__((ext_vector_type(16)));
typedef unsigned u32x4 __attribute__((ext_vector_type(4)));
typedef unsigned u32x2 __attribute__((ext_vector_type(2)));
typedef float f32x2_t __attribute__((ext_vector_type(2)));
typedef __bf16 bf16x2_t __attribute__((ext_vector_type(2)));
__device__ __forceinline__ unsigned pk2(float lo, float hi) { f32x2_t v = {lo, hi}; bf16x2_t b = __builtin_convertvector(v, bf16x2_t); return __builtin_bit_cast(unsigned, b); }
__device__ __forceinline__ float bf2f(unsigned short b) { return __uint_as_float(((unsigned)b) << 16); }
__device__ __forceinline__ float bflo(unsigned w) { return __uint_as_float(w << 16); }
__device__ __forceinline__ float bfhi(unsigned w) { return __uint_as_float(w & 0xffff0000u); }
__device__ __forceinline__ float fexp2(float x) { return __builtin_amdgcn_exp2f(x); }
__device__ __forceinline__ float flog2(float x) { return __builtin_amdgcn_logf(x); }
__device__ __forceinline__ float frcp(float x) { return __builtin_amdgcn_rcpf(x); }
__device__ __forceinline__ float fexp(float x) { return __builtin_amdgcn_exp2f(x * 1.4426950408889634f); }
__device__ __forceinline__ float sigmoidf_(float x) { return frcp(1.0f + fexp(-x)); }
__device__ __forceinline__ float siluf_(float x) { return x * sigmoidf_(x); }
__device__ __forceinline__ float rs_of(const float* st, int row) { return rsqrtf(st[row] * (1.0f / 1024.0f) + EPS); }
__device__ __forceinline__ int crow(int reg, int h) { return (reg & 3) + 8 * (reg >> 2) + 4 * h; }
#define MFMA32(a, b, c) __builtin_amdgcn_mfma_f32_32x32x16_bf16((a), (b), (c), 0, 0, 0)
__device__ __forceinline__ bf16x8 pack8(float a0, float a1, float a2, float a3, float a4, float a5, float a6, float a7) {
    u32x4 p; p.x = pk2(a0, a1); p.y = pk2(a2, a3); p.z = pk2(a4, a5); p.w = pk2(a6, a7); return __builtin_bit_cast(bf16x8, p);
}
#define PACK_STEP(x, s) pack8((x)[8 * (s)], (x)[8 * (s) + 1], (x)[8 * (s) + 2], (x)[8 * (s) + 3], (x)[8 * (s) + 4], (x)[8 * (s) + 5], (x)[8 * (s) + 6], (x)[8 * (s) + 7])
__device__ __forceinline__ bf16x8 cat4(s16x4 lo, s16x4 hi) { return __builtin_shufflevector(lo, hi, 0, 1, 2, 3, 4, 5, 6, 7); }

namespace pg8 {
#define PG8_LAS __attribute__((address_space(3)))
typedef unsigned short bf16_t;
typedef short bf16x8 __attribute__((ext_vector_type(8)));
typedef float f32x4 __attribute__((ext_vector_type(4)));
typedef unsigned u32x4 __attribute__((ext_vector_type(4)));
constexpr int BM = 256, BK = 64, HALF = 128, HTB = HALF * BK * 2  , STAGE_BYTES = 8 * HTB, NXCD = 8, WGM = 4;

__host__ __device__ __forceinline__ int lds_byte(int r, int c) { const int st = (r >> 4) * 2 + (c >> 5), rr = r & 15, cc = c & 31, ob = rr * 64 + cc * 2; return st * 1024 + (ob ^ (((ob >> 9) & 1) << 5)); }
__host__ __device__ __forceinline__ void stage_rc(int b, int& R, int& C) { const int st = b / 1024, sb = b % 1024, swz = sb ^ (((sb >> 9) & 1) << 5); R = (st >> 1) * 16 + swz / 64; C = (st & 1) * 32 + (swz % 64) / 2; }
__host__ __device__ __forceinline__ int perm32(int rho) { const int n = rho >> 4, i = rho & 15; return 8 * (i >> 2) + 4 * n + (i & 3); }

struct Unit { int pm, pn; };
struct Gemm { const bf16_t* A; const bf16_t* Bt; int M, N, K; };

struct StaticOrder {
    int nM, nN, nwg, G, c;
    __host__ __device__ void init(int M, int N, int G_, int c_) { nM = M / BM; nN = N / BM; nwg = nM * nN; G = G_; c = c_; }
    __host__ __device__ bool next(int i, Unit& u) const {
        const long L = (long)i * G + c; if (L >= nwg) return false;
        int wgid = (int)L; { const int q = nwg / NXCD, r = nwg % NXCD, xcd = wgid % NXCD, off = wgid / NXCD; wgid = (xcd < r ? xcd * (q + 1) : r * (q + 1) + (xcd - r) * q) + off; }
        const int nig = WGM * nN, gid = wgid / nig, fm = gid * WGM, gsz = (nM - fm) < WGM ? (nM - fm) : WGM;
        u.pm = fm + ((wgid % nig) % gsz); u.pn = (wgid % nig) / gsz; return true;
    }
    __device__ __forceinline__ void a_ready(const Unit&) const {}
    __device__ __forceinline__ void done(const Unit&) const {}
};

typedef unsigned u32x2 __attribute__((ext_vector_type(2)));
template <bool DRY, class T> __device__ __forceinline__ void stv(T* p, const T& v) { if constexpr (DRY) { asm volatile("" :: "v"(v)); } else { *p = v; } }
template <bool DRY, class T> __device__ __forceinline__ void stv_nt(T* p, const T& v) { if constexpr (DRY) { asm volatile("" :: "v"(v)); } else { __builtin_nontemporal_store(v, p); } }

template <bool DRY> struct EpiGU {
    static constexpr bool PERM = true, AFTER_DRAIN = false, KSEG = false;
    const float* st; bf16_t* act; int kv_tiles; int pad_; float* out; unsigned char* ws;
    __device__ __forceinline__ void operator()(const f32x4 (&acc)[2][2][4][2], const Unit& u, int wr, int wc, int fr, int fq) const {
        const int row0 = u.pm * BM + wr * 64 + fr;
        if (u.pn < kv_tiles) {
            const bool smp = u.pm >= 256;
            const size_t fo = u.pn == 0 ? (smp ? ::OFF_K_S : ::OFF_K_P) : (smp ? ::OFF_V_S : ::OFF_V_P);
            const size_t bo = u.pn == 0 ? (smp ? ::R_KSN : ::R_KP) : (smp ? ::R_VSN : ::R_VP);
            float* of = out + fo; bf16_t* ob = (bf16_t*)(ws + bo);
            const int rbase = smp ? 65536 : 0;
#pragma unroll
            for (int ai = 0; ai < 2; ++ai)
#pragma unroll
                for (int m = 0; m < 4; ++m) {
                    const int row = row0 + ai * HALF + m * 16; const float rs = ::rs_of(st, row); const size_t lr = (size_t)(row - rbase) * 256;
#pragma unroll
                    for (int bj = 0; bj < 2; ++bj) {
                        const int col = bj * HALF + wc * 32 + 8 * fq;
                        const f32x4 v0 = acc[ai][bj][m][0] * rs, v1 = acc[ai][bj][m][1] * rs;
                        stv<DRY>((f32x4*)(of + lr + col), v0); stv<DRY>((f32x4*)(of + lr + col + 4), v1);
                        u32x4 w; w.x = ::pk2(v0[0], v0[1]); w.y = ::pk2(v0[2], v0[3]); w.z = ::pk2(v1[0], v1[1]); w.w = ::pk2(v1[2], v1[3]);
                        stv<DRY>((u32x4*)(ob + lr + col), w);
                    }
                }
        } else {
            const int ct = u.pn - kv_tiles;
#pragma unroll
            for (int ai = 0; ai < 2; ++ai)
#pragma unroll
                for (int m = 0; m < 4; ++m) {
                    const int row = row0 + ai * HALF + m * 16; const float rs = ::rs_of(st, row);
                    const f32x4 g0 = acc[ai][0][m][0] * rs, g1 = acc[ai][0][m][1] * rs, u0 = acc[ai][1][m][0] * rs, u1 = acc[ai][1][m][1] * rs;
                    u32x4 w;
                    w.x = ::pk2(::siluf_(g0[0]) * u0[0], ::siluf_(g0[1]) * u0[1]); w.y = ::pk2(::siluf_(g0[2]) * u0[2], ::siluf_(g0[3]) * u0[3]);
                    w.z = ::pk2(::siluf_(g1[0]) * u1[0], ::siluf_(g1[1]) * u1[1]); w.w = ::pk2(::siluf_(g1[2]) * u1[2], ::siluf_(g1[3]) * u1[3]);
                    stv<DRY>((u32x4*)(act + (size_t)row * 2816 + ct * 128 + wc * 32 + 8 * fq), w);
                }
        }
    }
};

template <bool DRY> struct EpiQ {
    static constexpr bool PERM = true, AFTER_DRAIN = false, KSEG = false;
    const float* st; bf16_t* O;
    __device__ __forceinline__ void operator()(const f32x4 (&acc)[2][2][4][2], const Unit& u, int wr, int wc, int fr, int fq) const {
        const int row0 = u.pm * BM + wr * 64 + fr;
#pragma unroll
        for (int ai = 0; ai < 2; ++ai)
#pragma unroll
            for (int m = 0; m < 4; ++m) {
                const int row = row0 + ai * HALF + m * 16; const float rs = ::rs_of(st, row);
#pragma unroll
                for (int bj = 0; bj < 2; ++bj) {
                    const f32x4 v0 = acc[ai][bj][m][0] * rs, v1 = acc[ai][bj][m][1] * rs;
                    u32x4 w; w.x = ::pk2(v0[0], v0[1]); w.y = ::pk2(v0[2], v0[3]); w.z = ::pk2(v1[0], v1[1]); w.w = ::pk2(v1[2], v1[3]);
                    stv<DRY>((u32x4*)(O + (size_t)row * 1024 + u.pn * BM + bj * HALF + wc * 32 + 8 * fq), w);
                }
            }
    }
};

template <bool DRY> struct EpiIn {
    static constexpr bool PERM = true, AFTER_DRAIN = false, KSEG = false;
    const float* st; bf16_t* Z; bf16_t* XBC; float* DT;
    __device__ __forceinline__ void operator()(const f32x4 (&acc)[2][2][4][2], const Unit& u, int wr, int wc, int fr, int fq) const {
        const int row0 = u.pm * BM + wr * 64 + fr;
#pragma unroll
        for (int ai = 0; ai < 2; ++ai)
#pragma unroll
            for (int m = 0; m < 4; ++m) {
                const int row = row0 + ai * HALF + m * 16; const float rs = ::rs_of(st, row);
#pragma unroll
                for (int bj = 0; bj < 2; ++bj) {
                    const int cl = bj * HALF + wc * 32 + 8 * fq;
                    const f32x4 v0 = acc[ai][bj][m][0] * rs, v1 = acc[ai][bj][m][1] * rs;
                    if (u.pn < 20) {
                        u32x4 w; w.x = ::pk2(v0[0], v0[1]); w.y = ::pk2(v0[2], v0[3]); w.z = ::pk2(v1[0], v1[1]); w.w = ::pk2(v1[2], v1[3]);
                        bf16_t* dst = u.pn < 8 ? Z + (size_t)row * 2048 + u.pn * BM + cl : XBC + (size_t)row * 3072 + (u.pn - 8) * BM + cl;
                        stv<DRY>((u32x4*)dst, w);
                    } else if (cl < 32) {
                        stv<DRY>((f32x4*)(DT + (size_t)row * 32 + cl), v0); stv<DRY>((f32x4*)(DT + (size_t)row * 32 + cl + 4), v1);
                    }
                }
            }
    }
};

template <bool DRY> struct EpiProj {
    static constexpr bool PERM = false, AFTER_DRAIN = false, KSEG = false;
    bf16_t* P;
    __device__ __forceinline__ void operator()(const f32x4 (&acc)[2][2][4][2], const Unit& u, int wr, int wc, int fr, int fq) const {
        const int col0 = u.pn * BM + wc * 32 + 4 * fq;
#pragma unroll
        for (int ai = 0; ai < 2; ++ai)
#pragma unroll
            for (int m = 0; m < 4; ++m) {
                const size_t ro = (size_t)(u.pm * BM + ai * HALF + wr * 64 + m * 16 + fr) * 1024;
#pragma unroll
                for (int bj = 0; bj < 2; ++bj)
#pragma unroll
                    for (int n = 0; n < 2; ++n) { const f32x4 v = acc[ai][bj][m][n]; u32x2 w; w.x = ::pk2(v[0], v[1]); w.y = ::pk2(v[2], v[3]); stv<DRY>((u32x2*)(P + ro + col0 + bj * HALF + n * 16), w); }
            }
    }
};

__device__ __forceinline__ float grs_(const float* gst, int row, int g) { return rsqrtf(gst[(size_t)row * 4 + g] * (1.0f / 512.0f) + ::EPS); }
template <int MODE, bool DRY> struct EpiRes {
    static constexpr bool PERM = false, AFTER_DRAIN = false, KSEG = (MODE == 2);
    __device__ __forceinline__ void kscale(f32x4 (&acc)[2][2][4][2], const Unit& u, int seg, int wr, int wc, int fr, int fq) const {
        const int rowb = u.pm * BM + wr * 64 + fr;
#pragma unroll
        for (int ai = 0; ai < 2; ++ai)
#pragma unroll
            for (int m = 0; m < 4; ++m) {
                const int row = rowb + ai * HALF + m * 16;
                const float a = st_in[(size_t)row * 4 + seg - 1] * (1.0f / 512.0f) + ::EPS, b = st_in[(size_t)row * 4 + seg] * (1.0f / 512.0f) + ::EPS;
                const float ratio = sqrtf(b * ::frcp(a));
#pragma unroll
                for (int bj = 0; bj < 2; ++bj)
#pragma unroll
                    for (int n = 0; n < 2; ++n) acc[ai][bj][m][n] *= ratio;
            }
    }
    const float* res_p; const float* res_s; float* X; bf16_t* xb; float* st_out; float alpha; const float* st_in; const bf16_t* proj;
    __device__ __forceinline__ void operator()(const f32x4 (&acc)[2][2][4][2], const Unit& u, int wr, int wc, int fr, int fq) const {
        const int col0 = u.pn * BM + wc * 32 + 4 * fq;
        const float* rb = (u.pm < 256) ? res_p : res_s - (size_t)65536 * 1024;
        const int rowb = u.pm * BM + wr * 64 + fr;
        f32x4 rn[2][2]; u32x2 pn[2][2]; float rsn = 1.f;
        {   const size_t ro = (size_t)rowb * 1024;
#pragma unroll
            for (int bj = 0; bj < 2; ++bj)
#pragma unroll
                for (int n = 0; n < 2; ++n) { const int c = col0 + bj * HALF + n * 16; rn[bj][n] = *(const f32x4*)(rb + ro + c); if (MODE == 1) pn[bj][n] = *(const u32x2*)(proj + ro + c); }
            if (MODE == 1) rsn = ::rs_of(st_in, rowb); if (MODE == 2) rsn = grs_(st_in, rowb, 3);
        }
#pragma unroll
        for (int g = 0; g < 8; ++g) {
            const int ai = g >> 2, m = g & 3;
            const int row = rowb + ai * HALF + m * 16; const size_t ro = (size_t)row * 1024;
            f32x4 rc[2][2]; u32x2 pc[2][2]; const float rs = rsn;
#pragma unroll
            for (int bj = 0; bj < 2; ++bj)
#pragma unroll
                for (int n = 0; n < 2; ++n) { rc[bj][n] = rn[bj][n]; if (MODE == 1) pc[bj][n] = pn[bj][n]; }
            if (g < 7) {
                const int rown = rowb + ((g + 1) >> 2) * HALF + ((g + 1) & 3) * 16; const size_t ron = (size_t)rown * 1024;
#pragma unroll
                for (int bj = 0; bj < 2; ++bj)
#pragma unroll
                    for (int n = 0; n < 2; ++n) { const int c = col0 + bj * HALF + n * 16; rn[bj][n] = *(const f32x4*)(rb + ron + c); if (MODE == 1) pn[bj][n] = *(const u32x2*)(proj + ron + c); }
                if (MODE == 1) rsn = ::rs_of(st_in, rown); if (MODE == 2) rsn = grs_(st_in, rown, 3);
            }
            asm volatile("" ::: "memory");
            float ss = 0.f;
#pragma unroll
            for (int bj = 0; bj < 2; ++bj)
#pragma unroll
                for (int n = 0; n < 2; ++n) {
                    const int c = col0 + bj * HALF + n * 16;
                    const f32x4 r4 = rc[bj][n]; f32x4 v;
                    if (MODE == 0) v = r4 + acc[ai][bj][m][n] * alpha;
                    else if (MODE == 2) v = r4 + acc[ai][bj][m][n] * rs;
                    else { const u32x2 pw = pc[bj][n]; const f32x4 a = acc[ai][bj][m][n] * rs;
                           v[0] = r4[0] + ::sigmoidf_(a[0]) * ::bflo(pw.x); v[1] = r4[1] + ::sigmoidf_(a[1]) * ::bfhi(pw.x);
                           v[2] = r4[2] + ::sigmoidf_(a[2]) * ::bflo(pw.y); v[3] = r4[3] + ::sigmoidf_(a[3]) * ::bfhi(pw.y); }
                    ss += (v[0] * v[0] + v[1] * v[1]) + (v[2] * v[2] + v[3] * v[3]);
                    u32x2 w; w.x = ::pk2(v[0], v[1]); w.y = ::pk2(v[2], v[3]);
                    stv<DRY>((f32x4*)(X + ro + c), v); if (xb) stv<DRY>((u32x2*)(xb + ro + c), w);
                }
            ss += __shfl_xor(ss, 16); ss += __shfl_xor(ss, 32);
            if constexpr (DRY) { asm volatile("" :: "v"(ss)); } else { if (fq == 0) unsafeAtomicAdd(st_out + row, ss); }
            asm volatile("" ::: "memory");
        }
    }
};

template <class Epi, class Sched, bool ALIGN_EPI = false, bool SP2 = false>
__device__ __forceinline__ void gemm_phase(PG8_LAS unsigned char* lds, const Gemm g, const Sched& S, const Epi& E) {
    int tid_ = threadIdx.x; asm volatile("" : "+v"(tid_)); const int tid = tid_, wid = __builtin_amdgcn_readfirstlane(tid >> 6), lane = tid & 63, wr = wid >> 2, wc = wid & 3, fr = lane & 15, fq = lane >> 4;
    const int K = g.K, nt = K / BK;
    unsigned voffA[2], voffB[2];
#pragma unroll
    for (int i = 0; i < 2; ++i) { int R, C; stage_rc(tid * 16 + i * 8192, R, C); const int Rb = Epi::PERM ? ((R & ~31) + perm32(R & 31)) : R;
        voffA[i] = (unsigned)(R * K + C) * 2u; voffB[i] = (unsigned)(Rb * K + C) * 2u; }
    const size_t kstep = (size_t)(BK * 2);
    const size_t hstep = (size_t)HALF * K * 2;
    const size_t tstep = 2 * hstep;
    const unsigned ldsw = (unsigned)wid * 1024u;
    const int aoff = lds_byte(wr * 64 + fr, fq * 8), boff = lds_byte(wc * 32 + fr, fq * 8);
#define PG8_SA(b, h) (((b) * 2 + (h)) * HTB)
#define PG8_SB(b, h) ((4 + (b) * 2 + (h)) * HTB)
#define PG8_STAGE(bufoff, gbase, voff) do { _Pragma("unroll") for (int _i = 0; _i < 2; ++_i) \
        __builtin_amdgcn_global_load_lds((const unsigned*)((const char*)(gbase) + (voff)[_i]), (PG8_LAS unsigned*)(lds + (bufoff) + ldsw + _i * 8192), 16, 0, 0); } while (0)
#define PG8_LDA(dst, b, h) do { _Pragma("unroll") for (int m = 0; m < 4; ++m) _Pragma("unroll") for (int k = 0; k < 2; ++k) dst[m][k] = *(const PG8_LAS bf16x8*)(lds + PG8_SA(b, h) + aoff + m * 2048 + k * 1024); } while (0)
#define PG8_LDB(dst, b, h) do { _Pragma("unroll") for (int n = 0; n < 2; ++n) _Pragma("unroll") for (int k = 0; k < 2; ++k) dst[n][k] = *(const PG8_LAS bf16x8*)(lds + PG8_SB(b, h) + boff + n * 2048 + k * 1024); } while (0)
#define PG8_MMA(ai, bj, At, Bt) do { __builtin_amdgcn_s_setprio(1); _Pragma("unroll") for (int m = 0; m < 4; ++m) _Pragma("unroll") for (int n = 0; n < 2; ++n) _Pragma("unroll") for (int k = 0; k < 2; ++k) \
        acc[ai][bj][m][n] = __builtin_amdgcn_mfma_f32_16x16x32_bf16(Bt[n][k], At[m][k], acc[ai][bj][m][n], 0, 0, 0); __builtin_amdgcn_s_setprio(0); } while (0)
#define PG8_WAIT_V(n) asm volatile("s_waitcnt vmcnt(" #n ")" ::: "memory")
#define PG8_WAIT_L(n) asm volatile("s_waitcnt lgkmcnt(" #n ")" ::: "memory")
#define PG8_BAR __builtin_amdgcn_s_barrier()
#define PG8_SCHED __builtin_amdgcn_sched_barrier(0)
    Unit cur, nxt; int ui = 0;
    if (!S.next(0, cur)) return;
    f32x4 acc[2][2][4][2];
#pragma unroll
    for (int a = 0; a < 2; ++a)
#pragma unroll
        for (int b = 0; b < 2; ++b)
#pragma unroll
            for (int m = 0; m < 4; ++m)
#pragma unroll
                for (int n = 0; n < 2; ++n) acc[a][b][m][n] = (f32x4){0.f, 0.f, 0.f, 0.f};
    bf16x8 At[4][2], B0[2][2], B1[2][2];
    const char* cA = (const char*)g.A + (size_t)cur.pm * tstep; const char* cB = (const char*)g.Bt + (size_t)cur.pn * tstep;
    S.a_ready(cur);
    if constexpr (SP2) {
        PG8_STAGE(PG8_SB(0, 0), cB, voffB); PG8_STAGE(PG8_SB(0, 1), cB + hstep, voffB); PG8_STAGE(PG8_SA(0, 0), cA, voffA); PG8_STAGE(PG8_SA(0, 1), cA + hstep, voffA);
        if (wr == 1) PG8_BAR;
        PG8_WAIT_V(2); PG8_BAR;
        PG8_STAGE(PG8_SB(1, 0), cB + kstep, voffB); PG8_STAGE(PG8_SA(1, 0), cA + kstep, voffA); PG8_STAGE(PG8_SB(1, 1), cB + hstep + kstep, voffB);
        PG8_WAIT_V(6); PG8_BAR;
    } else {
        PG8_STAGE(PG8_SB(0, 0), cB, voffB); PG8_STAGE(PG8_SA(0, 0), cA, voffA); PG8_STAGE(PG8_SB(0, 1), cB + hstep, voffB); PG8_STAGE(PG8_SA(0, 1), cA + hstep, voffA);
        if (wr == 1) PG8_BAR;
        PG8_WAIT_V(4); PG8_BAR;
        PG8_STAGE(PG8_SB(1, 0), cB + kstep, voffB); PG8_STAGE(PG8_SA(1, 0), cA + kstep, voffA); PG8_STAGE(PG8_SB(1, 1), cB + hstep + kstep, voffB);
        PG8_WAIT_V(6); PG8_BAR;
    }
    for (;;) {
        const bool has_next = S.next(ui + 1, nxt);
        const char* nA = has_next ? (const char*)g.A + (size_t)nxt.pm * tstep : cA; const char* nB = has_next ? (const char*)g.Bt + (size_t)nxt.pn * tstep : cB;
        for (int t = 0; t < nt; t += 2) {
            const bool last = (t == nt - 2);
            const char* a1 = cA + (size_t)(t + 1) * kstep;
            const char* a2 = last ? nA : cA + (size_t)(t + 2) * kstep; const char* b2 = last ? nB : cB + (size_t)(t + 2) * kstep;
            const char* a3 = a2 + kstep; const char* b3 = b2 + kstep;
            if (last && has_next) S.a_ready(nxt);
            if constexpr (SP2) {
            PG8_LDB(B0, 0, 0); PG8_LDB(B1, 0, 1); PG8_SCHED; PG8_LDA(At, 0, 0); PG8_STAGE(PG8_SA(1, 1), a1 + hstep, voffA);
            PG8_WAIT_V(8); PG8_WAIT_L(0); PG8_BAR; PG8_MMA(0, 0, At, B0); PG8_MMA(0, 1, At, B1); PG8_BAR; PG8_SCHED;
            PG8_LDA(At, 0, 1); PG8_STAGE(PG8_SB(0, 0), b2, voffB); PG8_STAGE(PG8_SB(0, 1), b2 + hstep, voffB); PG8_STAGE(PG8_SA(0, 0), a2, voffA);
            PG8_WAIT_V(8); PG8_WAIT_L(0); PG8_BAR; PG8_MMA(1, 0, At, B0); PG8_MMA(1, 1, At, B1); PG8_BAR; PG8_SCHED;
            PG8_LDB(B0, 1, 0); PG8_LDB(B1, 1, 1); PG8_SCHED; PG8_LDA(At, 1, 0); PG8_STAGE(PG8_SA(0, 1), a2 + hstep, voffA);
            PG8_WAIT_V(8); PG8_WAIT_L(0); PG8_BAR; PG8_MMA(0, 0, At, B0); PG8_MMA(0, 1, At, B1); PG8_BAR; PG8_SCHED;
            PG8_LDA(At, 1, 1); PG8_STAGE(PG8_SB(1, 0), b3, voffB); PG8_STAGE(PG8_SB(1, 1), b3 + hstep, voffB); PG8_STAGE(PG8_SA(1, 0), a3, voffA);
            PG8_WAIT_V(8); PG8_WAIT_L(0); PG8_BAR; PG8_MMA(1, 0, At, B0); PG8_MMA(1, 1, At, B1); PG8_BAR; PG8_SCHED;
            } else {
            PG8_LDB(B0, 0, 0); PG8_SCHED; PG8_LDA(At, 0, 0); PG8_STAGE(PG8_SA(1, 1), a1 + hstep, voffA);
            PG8_WAIT_L(8); PG8_BAR; PG8_WAIT_L(0); PG8_MMA(0, 0, At, B0); PG8_BAR; PG8_SCHED;
            PG8_LDB(B1, 0, 1); PG8_STAGE(PG8_SB(0, 0), b2, voffB);
            PG8_BAR; PG8_WAIT_L(0); PG8_MMA(0, 1, At, B1); PG8_BAR;
            PG8_LDA(At, 0, 1); PG8_STAGE(PG8_SA(0, 0), a2, voffA);
            PG8_BAR; PG8_WAIT_L(0); PG8_MMA(1, 0, At, B0); PG8_BAR; PG8_SCHED;
            PG8_STAGE(PG8_SB(0, 1), b2 + hstep, voffB);
            PG8_WAIT_V(6); PG8_BAR; PG8_MMA(1, 1, At, B1); PG8_BAR;
            PG8_LDB(B0, 1, 0); PG8_SCHED; PG8_LDA(At, 1, 0); PG8_STAGE(PG8_SA(0, 1), a2 + hstep, voffA);
            PG8_WAIT_L(8); PG8_BAR; PG8_WAIT_L(0); PG8_MMA(0, 0, At, B0); PG8_BAR; PG8_SCHED;
            PG8_LDB(B1, 1, 1); PG8_STAGE(PG8_SB(1, 0), b3, voffB);
            PG8_BAR; PG8_WAIT_L(0); PG8_MMA(0, 1, At, B1); PG8_BAR;
            PG8_LDA(At, 1, 1); PG8_STAGE(PG8_SA(1, 0), a3, voffA);
            PG8_BAR; PG8_WAIT_L(0); PG8_MMA(1, 0, At, B0); PG8_BAR; PG8_SCHED;
            PG8_STAGE(PG8_SB(1, 1), b3 + hstep, voffB);
            PG8_WAIT_V(6); PG8_BAR; PG8_MMA(1, 1, At, B1); PG8_BAR;
            }
            if constexpr (Epi::KSEG) { if (((t + 2) & 7) == 0 && t + 2 < nt) E.kscale(acc, cur, (t + 2) >> 3, wr, wc, fr, fq); }
        }
        if constexpr (ALIGN_EPI) { if (wr == 0) PG8_BAR; }
        if constexpr (!Epi::AFTER_DRAIN) { E(acc, cur, wr, wc, fr, fq); S.done(cur); }
        if (!has_next) break;
#pragma unroll
        for (int a = 0; a < 2; ++a)
#pragma unroll
            for (int b = 0; b < 2; ++b)
#pragma unroll
                for (int m = 0; m < 4; ++m)
#pragma unroll
                    for (int n = 0; n < 2; ++n) acc[a][b][m][n] = (f32x4){0.f, 0.f, 0.f, 0.f};
        cur = nxt; cA = nA; cB = nB; ++ui;
        if constexpr (ALIGN_EPI) { if (wr == 1) PG8_BAR; }
    }
    PG8_WAIT_V(0);
    if constexpr (!ALIGN_EPI) { if (wr == 0) PG8_BAR; }
    PG8_BAR;
    if constexpr (Epi::AFTER_DRAIN) { E.fused(acc, cur, wr, wc, fr, fq, lds, wid, lane); S.done(cur); }
#undef PG8_SA
#undef PG8_SB
#undef PG8_STAGE
#undef PG8_LDA
#undef PG8_LDB
#undef PG8_MMA
#undef PG8_WAIT_V
#undef PG8_WAIT_L
#undef PG8_BAR
#undef PG8_SCHED
}
}

constexpr int LDS_BYTES = 155648;
struct Prm { const float* in[30]; float* out; unsigned char* ws; int lo, hi; };
#ifndef DRY_MASK
#define DRY_MASK 0
#endif
#ifndef MK_CGSYNC
#define MK_CGSYNC 0
#endif
constexpr size_t WS_BAR = 3 * MiB + 65536;
constexpr size_t WS_GST = 954 * MiB;

#define LDS_WAIT() asm volatile("s_waitcnt lgkmcnt(0)" ::: "memory")

__device__ __forceinline__ float wave_sum(float v) {
#pragma unroll
    for (int o = 1; o < 64; o <<= 1) v += __shfl_xor(v, o);
    return v;
}

__device__ __forceinline__ void tr_item(const float* __restrict__ W, int K, int N, const float* __restrict__ gain, float gs, bf16_t* WT, int drow0, int k0, int n0, LAS float* scr, int lane) {
#pragma unroll 8
    for (int i = 0; i < 32; ++i) { const int kk = 2 * i + (lane >> 5); const float g = gain ? gain[k0 + kk] * gs : gs; scr[kk * 33 + (lane & 31)] = W[(size_t)(k0 + kk) * N + n0 + (lane & 31)] * g; }
    LDS_WAIT();
    const int c = lane & 7;
#pragma unroll
    for (int j = 0; j < 4; ++j) { const int n = (lane >> 3) + 8 * j; const LAS float* s = scr + (8 * c) * 33 + n;
        u32x4 o; o.x = pk2(s[0 * 33], s[1 * 33]); o.y = pk2(s[2 * 33], s[3 * 33]); o.z = pk2(s[4 * 33], s[5 * 33]); o.w = pk2(s[6 * 33], s[7 * 33]);
        *(u32x4*)(WT + (size_t)(drow0 + n) * K + k0 + 8 * c) = o; }
    LDS_WAIT();
}
template <int MODE>
__device__ __forceinline__ void tr_job(const float* W, int K, int N, const float* gain, float gs, bf16_t* WT, int row_off, LAS float* scr, int gw, int ngw, int lane) {
    const int nblk = N / 32, nitems = (K / 64) * nblk;
    for (int it = gw; it < nitems; it += ngw) {
        const int kb = it / nblk, nb = it - kb * nblk, n0 = nb * 32;
        const int drow0 = (MODE == 1 ? 256 * (n0 >> 7) + (n0 & 127) : n0) + row_off;
        tr_item(W, K, N, gain, gs, WT, drow0, kb * 64, n0, scr, lane);
    }
}

template <int PART> __device__ __forceinline__ void p0_prologue(const Prm& P, LAS unsigned char* lds, const int blk, const int nblk) {
    int tid_ = threadIdx.x; asm volatile("" : "+v"(tid_)); const int tid = tid_, lane = tid & 63, wave = tid >> 6;
    const int gw = blk * 8 + wave, ngw = nblk * 8;
    LAS float* scr = (LAS float*)(lds + wave * 16384);
    bf16_t* WT = (bf16_t*)(P.ws + WS_WT);
    float* ST = (float*)(P.ws + WS_ST);
#pragma unroll
    for (int l = 0; l < 4; ++l) {
        const size_t ogu = l == 0 ? O_GU00 : l == 1 ? O_GU01 : l == 2 ? O_GU10 : O_GU11;
        const float* gain = P.in[8] + l * 1024;
        const bool gu_here = (l == 0 && PART == 0) || (l == 1 && PART == 3) || (l >= 2 && PART == 1);
        const bool d_here = (l == 0 && PART == 2) || (l == 1 && PART == 4) || (l >= 2 && PART == 1);
        if (gu_here) {
        tr_job<1>(P.in[9] + (size_t)l * D_STRIDE, 1024, 2816, gain, 1.f, WT + ogu, 0, scr, gw, ngw, lane);
        tr_job<1>(P.in[10] + (size_t)l * D_STRIDE, 1024, 2816, gain, 1.f, WT + ogu, 128, scr, gw, ngw, lane);
        }
        if (d_here) tr_job<0>(P.in[11] + (size_t)l * D_STRIDE, 2816, 1024, nullptr, 1.f, WT + O_D + (size_t)l * D_STRIDE, 0, scr, gw, ngw, lane);
    }
    if (PART == 2) {
    tr_job<0>(P.in[13], 1024, 5152, P.in[12], 1.f, WT + O_IN, 0, scr, gw, ngw, lane);
    { u32x4* z = (u32x4*)(WT + O_IN + (size_t)5152 * 1024); const int n16 = 224 * 1024 / 8; const u32x4 zz = {0u, 0u, 0u, 0u};
      for (int i = blk * 512 + tid; i < n16; i += nblk * 512) z[i] = zz; }
    }
    if (PART == 3) {
    tr_job<0>(P.in[20], 2048, 1024, P.in[19], 1.f, WT + O_OUT, 0, scr, gw, ngw, lane);
    }
    if (PART == 1) {
    tr_job<0>(P.in[22], 1024, 256, P.in[21], 1.f, WT + O_KV, 0, scr, gw, ngw, lane);
    tr_job<0>(P.in[23], 1024, 256, P.in[21], 1.f, WT + O_KV, 256, scr, gw, ngw, lane);
    tr_job<0>(P.in[24], 1024, 1024, P.in[12] + 1024, 0.125f * 1.4426950408889634f, WT + O_Q, 0, scr, gw, ngw, lane);
    tr_job<0>(P.in[25], 1024, 1024, nullptr, 1.f, WT + O_O, 0, scr, gw, ngw, lane);
    tr_job<0>(P.in[27], 1024, 1024, P.in[26], 1.f, WT + O_PG0, 0, scr, gw, ngw, lane);
    tr_job<0>(P.in[27] + 1048576, 1024, 1024, P.in[26] + 1024, 1.f, WT + O_PG1, 0, scr, gw, ngw, lane);
    tr_job<0>(P.in[28], 256, 1024, nullptr, 1.f, WT + O_PP0, 0, scr, gw, ngw, lane);
    tr_job<0>(P.in[28] + 262144, 256, 1024, nullptr, 1.f, WT + O_PP1, 0, scr, gw, ngw, lane);
    }
    if (PART == 0) {
    { float* z = ST + MA; for (int i = blk * 512 + tid; i < 8 * MA; i += nblk * 512) z[i] = 0.f;
      float* zg = (float*)(P.ws + WS_GST); for (int i = blk * 512 + tid; i < 4 * MA; i += nblk * 512) zg[i] = 0.f;
      if (blk == 0 && tid < 64) ((unsigned*)(P.ws + WS_CNT))[tid] = 0u;
      if (blk == 1) for (int i = tid; i < 3456; i += 512) ((unsigned*)(P.ws + WS_BAR))[i] = 0u; }
    bf16_t* XB = (bf16_t*)(P.ws + WS_XB);
    for (int row = gw; row < MA; row += 2 * ngw) {
        const int row2 = row + ngw; const bool has2 = row2 < MA; const int r2 = has2 ? row2 : row;
        const float* xr = row < MP ? P.in[0] + (size_t)row * 1024 : P.in[1] + (size_t)(row - MP) * 1024;
        const float* xr2 = r2 < MP ? P.in[0] + (size_t)r2 * 1024 : P.in[1] + (size_t)(r2 - MP) * 1024;
        f32x4 v[4], w[4];
#pragma unroll
        for (int j = 0; j < 4; ++j) v[j] = *(const f32x4*)(xr + 256 * j + 4 * lane);
#pragma unroll
        for (int j = 0; j < 4; ++j) w[j] = *(const f32x4*)(xr2 + 256 * j + 4 * lane);
        float s = 0.f, s2 = 0.f;
#pragma unroll
        for (int j = 0; j < 4; ++j) { s += (v[j][0] * v[j][0] + v[j][1] * v[j][1]) + (v[j][2] * v[j][2] + v[j][3] * v[j][3]);
            u32x2 o; o.x = pk2(v[j][0], v[j][1]); o.y = pk2(v[j][2], v[j][3]); *(u32x2*)(XB + (size_t)row * 1024 + 256 * j + 4 * lane) = o; }
        s = wave_sum(s);
        if (lane == 0) ST[row] = s;
        if (has2) {
#pragma unroll
            for (int j = 0; j < 4; ++j) { s2 += (w[j][0] * w[j][0] + w[j][1] * w[j][1]) + (w[j][2] * w[j][2] + w[j][3] * w[j][3]);
                u32x2 o; o.x = pk2(w[j][0], w[j][1]); o.y = pk2(w[j][2], w[j][3]); *(u32x2*)(XB + (size_t)row2 * 1024 + 256 * j + 4 * lane) = o; }
            s2 = wave_sum(s2);
            if (lane == 0) ST[row2] = s2;
        }
    }
    }
    if (PART >= 4) {
    bf16_t* PB = (bf16_t*)(P.ws + WS_PB);
    const int r_lo = PART == 4 ? 0 : (PART == 5 ? MA : MA + MA / 2), r_hi = PART == 4 ? MA : (PART == 5 ? MA + MA / 2 : 2 * MA);
    for (int r0 = r_lo + gw; r0 < r_hi; r0 += 4 * ngw) {
        f32x4 v[4];
#pragma unroll
        for (int k = 0; k < 4; ++k) {
            const int r2 = (r0 + k * ngw < r_hi) ? r0 + k * ngw : r0;
            const int l = r2 >= MA ? 1 : 0, row = r2 - l * MA;
            const float* pr = row < MP ? P.in[2] + ((size_t)l * MP + row) * 256 : P.in[3] + ((size_t)l * MS + (row - MP)) * 256;
            v[k] = *(const f32x4*)(pr + 4 * lane);
        }
#pragma unroll
        for (int k = 0; k < 4; ++k) {
            const int r2 = r0 + k * ngw;
            if (r2 < r_hi) { u32x2 w; w.x = pk2(v[k][0], v[k][1]); w.y = pk2(v[k][2], v[k][3]); *(u32x2*)(PB + (size_t)r2 * 256 + 4 * lane) = w; }
        }
    }
    }
}

__device__ __forceinline__ void final_norm_phase(const Prm& P) {
    int tid_ = threadIdx.x; asm volatile("" : "+v"(tid_)); const int tid = tid_, lane = tid & 63, wave = tid >> 6;
    const int gw = blockIdx.x * 8 + wave, ngw = gridDim.x * 8;
    const float* st = (const float*)(P.ws + WS_ST) + (size_t)8 * MA; const float* g = P.in[29];
    f32x4 gg[4];
#pragma unroll
    for (int j = 0; j < 4; ++j) gg[j] = *(const f32x4*)(g + 256 * j + 4 * lane);
    for (int row = gw; row < MA; row += 2 * ngw) {
        const int row2 = row + ngw; const bool has2 = row2 < MA;
        float* xr = P.out + (size_t)row * 1024; float* xr2 = P.out + (size_t)(has2 ? row2 : row) * 1024;
        f32x4 v[4], w[4];
#pragma unroll
        for (int j = 0; j < 4; ++j) v[j] = *(const f32x4*)(xr + 256 * j + 4 * lane);
#pragma unroll
        for (int j = 0; j < 4; ++j) w[j] = *(const f32x4*)(xr2 + 256 * j + 4 * lane);
        const float rs = rs_of(st, row), rs2 = rs_of(st, has2 ? row2 : row);
#pragma unroll
        for (int j = 0; j < 4; ++j) *(f32x4*)(xr + 256 * j + 4 * lane) = v[j] * rs * gg[j];
        if (has2) {
#pragma unroll
            for (int j = 0; j < 4; ++j) *(f32x4*)(xr2 + 256 * j + 4 * lane) = w[j] * rs2 * gg[j];
        }
    }
}

constexpr int SS_CM = 0, SS_BM = 8704, SS_BT = 17408, SS_X0 = 27648, SS_X2 = 48128, SS_ZS = 68608, SS_DTV = 85504, SS_ACS = 86528;
constexpr int CMS = 272, BTS = 80, XS = 80, ZSS = 528;

template <bool DRY> __device__ __forceinline__ void ssd_phase(const Prm& P, LAS unsigned char* lds) {
    int tid_ = threadIdx.x; asm volatile("" : "+v"(tid_)); const int tid0 = tid_;
    bf16_t* Zb = (bf16_t*)(P.ws + R_Z); const bf16_t* XBC = (const bf16_t*)(P.ws + R_XBC); const float* DT = (const float*)(P.ws + WS_DT);
    float* GST = (float*)(P.ws + WS_GST);
    const float* conv_w = P.in[14]; const float* conv_b = P.in[15]; const float* dt_bias = P.in[16]; const float* a_log = P.in[17]; const float* dskip = P.in[18];
    for (int unit = blockIdx.x; unit < 512; unit += gridDim.x) {
        const bool smp = unit >= 256; const int uu = unit & 255, b = uu >> 3, g = (uu >> 1) & 3, hf = uu & 1;
        const int L = smp ? DSEQ : SEQ, nch = L / 32; const size_t row_base = smp ? (size_t)MP + b * 32 : (size_t)b * 2048;
        int tidu = tid0; asm volatile("" : "+v"(tidu));
        const int head = g * 8 + hf * 4 + (tidu >> 7);
        float* so = P.out + (smp ? OFF_SSM_S : OFF_SSM_P) + ((size_t)(b * 32 + head) * 64) * 128;
        f32x16 ST[4];
        { const int r = tidu & 31, hh = (tidu >> 5) & 1, ph = (tidu >> 6) & 1;
#pragma unroll
        for (int nt = 0; nt < 4; ++nt) {
                if (smp) { const float* si = P.in[4] + ((size_t)(b * 32 + head) * 64) * 128;
#pragma unroll
                    for (int q = 0; q < 4; ++q) { const f32x4 v = *(const f32x4*)(si + (size_t)(32 * ph + r) * 128 + 32 * nt + 8 * q + 4 * hh);
                        ST[nt][4 * q] = v[0]; ST[nt][4 * q + 1] = v[1]; ST[nt][4 * q + 2] = v[2]; ST[nt][4 * q + 3] = v[3]; }
                } else {
#pragma unroll
                    for (int i = 0; i < 16; ++i) ST[nt][i] = 0.f;
                }
            }
        }
        const float Dh = dskip[head];
        float dtr = 0.f;
        if (tidu < 128) dtr = DT[(row_base + (tidu & 31)) * 32 + g * 8 + hf * 4 + (tidu >> 5)];
        float cw[2][2][5]; unsigned raw[2][11]; u32x4 zreg[2];
        {
            const bf16_t* xb0 = XBC + row_base * 3072;
#pragma unroll
            for (int k = 0; k < 2; ++k) {
                const int idx = tidu + 512 * k, pr = idx & 255, q = idx >> 8, lc = 2 * pr;
                const int gc = lc < 256 ? g * 512 + hf * 256 + lc : (lc < 384 ? 2048 + g * 128 + (lc - 256) : 2560 + g * 128 + (lc - 384));
#pragma unroll
                for (int c2 = 0; c2 < 2; ++c2) { cw[k][c2][0] = conv_w[gc + c2]; cw[k][c2][1] = conv_w[3072 + gc + c2]; cw[k][c2][2] = conv_w[2 * 3072 + gc + c2]; cw[k][c2][3] = conv_w[3 * 3072 + gc + c2]; cw[k][c2][4] = conv_b[gc + c2]; }
#pragma unroll
                for (int i = 0; i < 11; ++i) raw[k][i] = *(const unsigned*)(xb0 + (8 * q - 3 + i) * 3072 + gc);
                const int zr = idx >> 5, c16 = idx & 31;
                zreg[k] = *(const u32x4*)(Zb + (row_base + zr) * 2048 + g * 512 + hf * 256 + c16 * 8);
            }
        }
#define SSD_STAGE0(CH, TID) do { if ((TID) < 128) { const int h4_ = (TID) >> 5, j_ = (TID) & 31, hd_ = g * 8 + hf * 4 + h4_; \
            const float v_ = dtr + dt_bias[hd_]; \
            if ((CH) + 1 < nch) dtr = DT[(row_base + ((CH) + 1) * 32 + j_) * 32 + hd_]; \
            const float dt_ = v_ > 20.f ? v_ : 0.6931471805599453f * flog2(1.0f + fexp(v_)); \
            float acs_ = dt_ * (-fexp(a_log[hd_])); \
            _Pragma("unroll") for (int o_ = 1; o_ < 32; o_ <<= 1) { const float t_ = __shfl_up(acs_, o_, 32); if (j_ >= o_) acs_ += t_; } \
            ((LAS float*)(lds + SS_DTV))[((CH) & 1) * 128 + h4_ * 32 + j_] = dt_; ((LAS float*)(lds + SS_ACS))[((CH) & 1) * 128 + h4_ * 32 + j_] = acs_; } } while (0)
        __syncthreads();
        SSD_STAGE0(0, tidu);
        for (int ch = 0; ch < nch; ++ch) {
            const int t0 = ch * 32;
            int tidc = tid0; asm volatile("" : "+v"(tidc));
            const int tid = tidc, lane = tid & 63, wv = tid >> 6, hw = wv >> 1, ph = wv & 1, r = lane & 31, hh = lane >> 5;
            LAS float* DTV = (LAS float*)(lds + SS_DTV) + (ch & 1) * 128; LAS float* ACS = (LAS float*)(lds + SS_ACS) + (ch & 1) * 128;
            __syncthreads();
            {
            const bf16_t* xbase = XBC + (row_base + t0) * 3072;
            const float* scbase = P.in[5] + (size_t)b * 3 * 3072;
#pragma unroll
            for (int k = 0; k < 2; ++k) {
                const int idx = tid + 512 * k, pr = idx & 255, q = idx >> 8, lc = 2 * pr;
                const int gc = lc < 256 ? g * 512 + hf * 256 + lc : (lc < 384 ? 2048 + g * 128 + (lc - 256) : 2560 + g * 128 + (lc - 384));
                if (t0 == 0) {
                    unsigned f0 = 0u, f1 = 0u, f2 = 0u;
                    if (smp) { f0 = pk2(scbase[gc], scbase[gc + 1]); f1 = pk2(scbase[3072 + gc], scbase[3072 + gc + 1]); f2 = pk2(scbase[2 * 3072 + gc], scbase[2 * 3072 + gc + 1]); }
                    if (q == 0) { raw[k][0] = f0; raw[k][1] = f1; raw[k][2] = f2; }
                }
                unsigned oa[4], ob[4];
                float fa[8], fb[8];
#pragma unroll
                for (int i = 0; i < 8; ++i) fa[i] = siluf_(cw[k][0][4] + cw[k][0][0] * bflo(raw[k][i]) + cw[k][0][1] * bflo(raw[k][i + 1]) + cw[k][0][2] * bflo(raw[k][i + 2]) + cw[k][0][3] * bflo(raw[k][i + 3]));
#pragma unroll
                for (int i = 0; i < 8; ++i) fb[i] = siluf_(cw[k][1][4] + cw[k][1][0] * bfhi(raw[k][i]) + cw[k][1][1] * bfhi(raw[k][i + 1]) + cw[k][1][2] * bfhi(raw[k][i + 2]) + cw[k][1][3] * bfhi(raw[k][i + 3]));
#pragma unroll
                for (int i = 0; i < 4; ++i) { oa[i] = pk2(fa[2 * i], fa[2 * i + 1]); ob[i] = pk2(fb[2 * i], fb[2 * i + 1]); }
                if (lc < 256) {
                    const int h4 = lc >> 6, p = lc & 63; const float aend = ACS[h4 * 32 + 31];
                    *(LAS u32x4*)(lds + SS_X0 + (h4 * 64 + p) * XS + 16 * q) = (u32x4){oa[0], oa[1], oa[2], oa[3]};
                    *(LAS u32x4*)(lds + SS_X0 + (h4 * 64 + p + 1) * XS + 16 * q) = (u32x4){ob[0], ob[1], ob[2], ob[3]};
#pragma unroll
                    for (int i = 0; i < 8; ++i) { const int j = 8 * q + i; const float f = DTV[h4 * 32 + j] * fexp(aend - ACS[h4 * 32 + j]); fa[i] *= f; fb[i] *= f; }
#pragma unroll
                    for (int i = 0; i < 4; ++i) { oa[i] = pk2(fa[2 * i], fa[2 * i + 1]); ob[i] = pk2(fb[2 * i], fb[2 * i + 1]); }
                    *(LAS u32x4*)(lds + SS_X2 + (h4 * 64 + p) * XS + 16 * q) = (u32x4){oa[0], oa[1], oa[2], oa[3]};
                    *(LAS u32x4*)(lds + SS_X2 + (h4 * 64 + p + 1) * XS + 16 * q) = (u32x4){ob[0], ob[1], ob[2], ob[3]};
                } else {
                    const int n = lc < 384 ? lc - 256 : lc - 384; const int rowbase = lc < 384 ? SS_BM : SS_CM;
#pragma unroll
                    for (int i = 0; i < 8; ++i) *(LAS unsigned*)(lds + rowbase + (8 * q + i) * CMS + n * 2) = pk2(fa[i], fb[i]);
                    if (lc < 384) {
                        *(LAS u32x4*)(lds + SS_BT + n * BTS + 16 * q) = (u32x4){oa[0], oa[1], oa[2], oa[3]};
                        *(LAS u32x4*)(lds + SS_BT + (n + 1) * BTS + 16 * q) = (u32x4){ob[0], ob[1], ob[2], ob[3]};
                    }
                }
            }
#pragma unroll
            for (int k = 0; k < 2; ++k) { const int idx = tid + 512 * k, zr = idx >> 5, c16 = idx & 31; *(LAS u32x4*)(lds + SS_ZS + zr * ZSS + c16 * 16) = zreg[k]; }
            if (ch + 1 < nch) {
#pragma unroll
                for (int k = 0; k < 2; ++k) {
                    const int idx = tid + 512 * k, pr = idx & 255, q = idx >> 8, lc = 2 * pr;
                    const int gc = lc < 256 ? g * 512 + hf * 256 + lc : (lc < 384 ? 2048 + g * 128 + (lc - 256) : 2560 + g * 128 + (lc - 384));
#pragma unroll
                    for (int i = 0; i < 11; ++i) raw[k][i] = *(const unsigned*)(xbase + (32 + 8 * q - 3 + i) * 3072 + gc);
                    const int zr = idx >> 5, c16 = idx & 31;
                    zreg[k] = *(const u32x4*)(Zb + (row_base + t0 + 32 + zr) * 2048 + g * 512 + hf * 256 + c16 * 8);
                }
            }
            }
            __syncthreads();
            {
                const float acs_i = ACS[hw * 32 + r];
                f32x16 gt;
#pragma unroll
                for (int i = 0; i < 16; ++i) gt[i] = 0.f;
#pragma unroll
                for (int s = 0; s < 8; ++s) {
                    const bf16x8 a = *(const LAS bf16x8*)(lds + SS_BM + r * CMS + (16 * s + 8 * hh) * 2);
                    const bf16x8 bq = *(const LAS bf16x8*)(lds + SS_CM + r * CMS + (16 * s + 8 * hh) * 2);
                    gt = MFMA32(a, bq, gt);
                }
#pragma unroll
                for (int i = 0; i < 16; ++i) { const int j = crow(i, hh); const float aj = ACS[hw * 32 + j], dj = DTV[hw * 32 + j];
                    gt[i] = (j <= r) ? gt[i] * fexp(acs_i - aj) * dj : 0.f; }
                const bf16x8 ga0 = PACK_STEP(gt, 0), ga1 = PACK_STEP(gt, 1);
                __builtin_amdgcn_sched_barrier(0);
                f32x16 y;
#pragma unroll
                for (int i = 0; i < 16; ++i) y[i] = 0.f;
                const int xrow = (hw * 64 + 32 * ph + r) * XS;
#pragma unroll
                for (int nt = 0; nt < 4; ++nt)
#pragma unroll
                    for (int s = 0; s < 2; ++s) {
                        const s16x4 lo = *(const LAS s16x4*)(lds + SS_CM + r * CMS + (32 * nt + 16 * s + 4 * hh) * 2);
                        const s16x4 hi = *(const LAS s16x4*)(lds + SS_CM + r * CMS + (32 * nt + 16 * s + 8 + 4 * hh) * 2);
                        const bf16x8 sb = s == 0 ? PACK_STEP(ST[nt], 0) : PACK_STEP(ST[nt], 1);
                        y = MFMA32(cat4(lo, hi), sb, y);
                    }
#pragma unroll
                for (int i = 0; i < 16; ++i) y[i] *= fexp(ACS[hw * 32 + crow(i, hh)]);
#pragma unroll
                for (int s = 0; s < 2; ++s) {
                    const s16x4 lo = *(const LAS s16x4*)(lds + SS_X0 + xrow + (16 * s + 4 * hh) * 2);
                    const s16x4 hi = *(const LAS s16x4*)(lds + SS_X0 + xrow + (16 * s + 8 + 4 * hh) * 2);
                    y = MFMA32(s == 0 ? ga0 : ga1, cat4(lo, hi), y);
                }
#pragma unroll
                for (int q = 0; q < 4; ++q) {
                    const s16x4 xv = *(const LAS s16x4*)(lds + SS_X0 + xrow + (8 * q + 4 * hh) * 2);
#pragma unroll
                    for (int e = 0; e < 4; ++e) {
                        const int i = 8 * q + 4 * hh + e;
                        LAS unsigned short* zp = (LAS unsigned short*)(lds + SS_ZS + i * ZSS + (hw * 64 + 32 * ph + r) * 2);
                        const float zv = bf2f(*zp);
                        const float yv = (y[4 * q + e] + Dh * bf2f((unsigned short)xv[e])) * siluf_(zv);
                        *zp = (unsigned short)(pk2(yv, 0.f) & 0xffffu);
                    }
                }
                const float dec = fexp(ACS[hw * 32 + 31]);
#pragma unroll
                for (int nt = 0; nt < 4; ++nt) {
#pragma unroll
                    for (int i = 0; i < 16; ++i) ST[nt][i] *= dec;
#pragma unroll
                    for (int s = 0; s < 2; ++s) {
                        const bf16x8 a = *(const LAS bf16x8*)(lds + SS_BT + (32 * nt + r) * BTS + (16 * s + 8 * hh) * 2);
                        const bf16x8 bq = *(const LAS bf16x8*)(lds + SS_X2 + xrow + (16 * s + 8 * hh) * 2);
                        ST[nt] = MFMA32(a, bq, ST[nt]);
                    }
                }
            }
            __syncthreads();
            if (ch + 1 < nch) SSD_STAGE0(ch + 1, tid);
            {
                const int i = tid >> 4, sub = tid & 15;
                u32x4 v[2]; float ss = 0.f;
#pragma unroll
                for (int k = 0; k < 2; ++k) { v[k] = *(const LAS u32x4*)(lds + SS_ZS + i * ZSS + sub * 32 + k * 16);
#pragma unroll
                    for (int e = 0; e < 4; ++e) { const float a = bflo(v[k][e]), c = bfhi(v[k][e]); ss += a * a + c * c; } }
                ss += __shfl_xor(ss, 1); ss += __shfl_xor(ss, 2); ss += __shfl_xor(ss, 4); ss += __shfl_xor(ss, 8);
                if constexpr (DRY) { asm volatile("" :: "v"(ss), "v"(v[0]), "v"(v[1])); }
                else {
                    if (sub == 0) unsafeAtomicAdd(GST + (row_base + t0 + i) * 4 + g, ss);
#pragma unroll
                    for (int k = 0; k < 2; ++k) *(u32x4*)(Zb + (row_base + t0 + i) * 2048 + g * 512 + hf * 256 + sub * 16 + k * 8) = v[k];
                }
            }
        }
        int tide = tid0; asm volatile("" : "+v"(tide));
        const int tid = tide, r = tide & 31, hh = (tide >> 5) & 1, ph = (tide >> 6) & 1;
#pragma unroll
        for (int nt = 0; nt < 4; ++nt)
#pragma unroll
            for (int q = 0; q < 4; ++q) { f32x4 v; v[0] = ST[nt][4 * q]; v[1] = ST[nt][4 * q + 1]; v[2] = ST[nt][4 * q + 2]; v[3] = ST[nt][4 * q + 3];
                *(f32x4*)(so + (size_t)(32 * ph + r) * 128 + 32 * nt + 8 * q + 4 * hh) = v; }
        float* co = P.out + (smp ? OFF_CONV_S : OFF_CONV_P) + (size_t)b * 3 * 3072;
        for (int idx = tid; idx < 3 * 512; idx += 512) { const int rr = idx >> 9, lc = idx & 511;
            if (lc >= 256 && hf) continue;
            const int gc = lc < 256 ? g * 512 + hf * 256 + lc : (lc < 384 ? 2048 + g * 128 + (lc - 256) : 2560 + g * 128 + (lc - 384));
            co[rr * 3072 + gc] = bf2f(XBC[(row_base + L - 3 + rr) * 3072 + gc]); }
    }
#undef SSD_STAGE0
}

constexpr int AT_K = 0, AT_V = 18432, AT_U = 36864, AT_F = 36880;
constexpr float SB_STICK_EPS = 1.17549435e-38f;
constexpr int KS_ = 144;
constexpr int N_ATT_UNITS = 128 + 4096;

template <bool DIAG> __device__ __forceinline__ void sb_softcum(f32x16& p0, f32x16& p1, float& R, const int kbase, const int qpos, const int hh) {
    float run = R;
#pragma unroll
    for (int t = 1; t >= 0; --t) {
#pragma unroll
        for (int g4 = 3; g4 >= 0; --g4) {
            float s4[4], e4[4]; bool ok[4];
#pragma unroll
            for (int e = 0; e < 4; ++e) {
                const float u = t ? p1[4 * g4 + e] : p0[4 * g4 + e];
                ok[e] = !DIAG || (kbase + 32 * t + 8 * g4 + e < qpos);
                const float ex = fexp2(fminf(u, 64.f));
                const float rr = frcp(1.0f + ex);
                s4[e] = ok[e] ? ex : 0.f;
                e4[e] = ok[e] ? rr : 1.f;
            }
            e4[2] *= e4[3]; e4[1] *= e4[2]; e4[0] *= e4[1];
            const auto sw = __builtin_amdgcn_permlane32_swap(__float_as_uint(e4[0]), __float_as_uint(e4[0]), false, false);
            const float lowT = __uint_as_float(sw[0]), highT = __uint_as_float(sw[1]);
            const float off = hh == 0 ? run * highT : run;
            run *= lowT * highT;
#pragma unroll
            for (int e = 0; e < 4; ++e) {
                const float a = s4[e] * e4[e] * off;
                if (t) p1[4 * g4 + e] = a; else p0[4 * g4 + e] = a;
            }
        }
    }
    R = run;
}

template <bool DRY> __device__ __forceinline__ void attn_phase(const Prm& P, LAS unsigned char* lds) {
    int tid_ = threadIdx.x; asm volatile("" : "+v"(tid_)); const int tid = tid_, lane = tid & 63, w = tid >> 6, r = lane & 31, hh = lane >> 5;
    bf16_t* QO = (bf16_t*)(P.ws + R_QO);
    const bf16_t* KP = (const bf16_t*)(P.ws + R_KP); const bf16_t* VP = (const bf16_t*)(P.ws + R_VP);
    const bf16_t* KSN = (const bf16_t*)(P.ws + R_KSN); const bf16_t* VSN = (const bf16_t*)(P.ws + R_VSN);
    const float* CK = P.in[6]; const float* CV = P.in[7];
    unsigned* counter = (unsigned*)(P.ws + WS_CNT) + (DRY ? 16 : 0);
    LAS unsigned* uw = (LAS unsigned*)(lds + AT_U);
    const int lkey = tid >> 3, ld8 = (tid & 7) * 8;
    int slot = 0;
    if (tid == 0) uw[0] = atomicAdd(counter, 1u);
    for (;;) {
        __syncthreads();
        const int unit = (int)uw[slot];
        if (unit >= N_ATT_UNITS) break;
        if (tid == 0) uw[slot ^ 1] = atomicAdd(counter, 1u);
        slot ^= 1;
        const bool smp = unit < 128;
        int b, kvh, qb;
        if (smp) { b = unit >> 2; kvh = unit & 3; qb = 64; }
        else { const int u2 = unit - 128; qb = 31 - (u2 >> 7); b = (u2 & 127) >> 2; kvh = u2 & 3; }
        const int nblk = qb + 1;
        const bool active = smp ? (w < 4) : true;
        const int head = smp ? kvh * 4 + (w & 3) : kvh * 4 + (w >> 1);
        const int qpos = smp ? PAST + r : 64 * qb + 32 * (w & 1) + r;
        const size_t qrow = smp ? (size_t)MP + b * 32 + r : (size_t)b * 2048 + qpos;
        bf16x8 qf[4];
#pragma unroll
        for (int s = 0; s < 4; ++s) qf[s] = *(const bf16x8*)(QO + qrow * 1024 + head * 64 + 16 * s + 8 * hh);
        f32x16 o[2];
#pragma unroll
        for (int d = 0; d < 2; ++d)
#pragma unroll
            for (int i = 0; i < 16; ++i) o[d][i] = 0.f;
        float R = 1.f;
        u32x4 kreg, vreg;
#define ATT_FETCH(kb) do { const int key = 64 * (kb) + lkey; \
            if (smp && (kb) < 64) { const float* kp_ = CK + (((size_t)b * 4096 + key) * 4 + kvh) * 64 + ld8; const float* vp_ = CV + (((size_t)b * 4096 + key) * 4 + kvh) * 64 + ld8; \
                const f32x4 k0 = *(const f32x4*)kp_, k1 = *(const f32x4*)(kp_ + 4), v0 = *(const f32x4*)vp_, v1 = *(const f32x4*)(vp_ + 4); \
                kreg.x = pk2(k0[0], k0[1]); kreg.y = pk2(k0[2], k0[3]); kreg.z = pk2(k1[0], k1[1]); kreg.w = pk2(k1[2], k1[3]); \
                vreg.x = pk2(v0[0], v0[1]); vreg.y = pk2(v0[2], v0[3]); vreg.z = pk2(v1[0], v1[1]); vreg.w = pk2(v1[2], v1[3]); } \
            else if (smp) { kreg = *(const u32x4*)(KSN + ((size_t)b * 32 + (lkey & 31)) * 256 + kvh * 64 + ld8); vreg = *(const u32x4*)(VSN + ((size_t)b * 32 + (lkey & 31)) * 256 + kvh * 64 + ld8); \
                            if (lkey >= 32) { kreg = (u32x4){0u, 0u, 0u, 0u}; vreg = kreg; } } \
            else { kreg = *(const u32x4*)(KP + ((size_t)b * 2048 + key) * 256 + kvh * 64 + ld8); vreg = *(const u32x4*)(VP + ((size_t)b * 2048 + key) * 256 + kvh * 64 + ld8); } } while (0)
#define ATT_STORE(buf) do { *(LAS u32x4*)(lds + AT_K + (buf) * 9216 + lkey * KS_ + ld8 * 2) = kreg; \
            LAS unsigned short* vt_ = (LAS unsigned short*)(lds + AT_V + (buf) * 9216 + ld8 * KS_ + (lkey ^ ((tid & 7) << 3)) * 2); \
            vt_[0 * 72] = (unsigned short)(vreg.x & 0xffffu); vt_[1 * 72] = (unsigned short)(vreg.x >> 16); vt_[2 * 72] = (unsigned short)(vreg.y & 0xffffu); vt_[3 * 72] = (unsigned short)(vreg.y >> 16); \
            vt_[4 * 72] = (unsigned short)(vreg.z & 0xffffu); vt_[5 * 72] = (unsigned short)(vreg.z >> 16); vt_[6 * 72] = (unsigned short)(vreg.w & 0xffffu); vt_[7 * 72] = (unsigned short)(vreg.w >> 16); } while (0)
        LAS unsigned* fl = (LAS unsigned*)(lds + AT_F);
        if (tid < 3) fl[tid] = 0u;
        ATT_FETCH(qb);
        ATT_STORE(0);
        __syncthreads();
        for (int it = 0; it < nblk; ++it) {
            const int kb = qb - it, buf = it & 1;
            if (it + 1 < nblk) ATT_FETCH(kb - 1);
            if (active) {
                const LAS unsigned char* Kb = lds + AT_K + buf * 9216; const LAS unsigned char* Vb = lds + AT_V + buf * 9216;
                f32x16 p0, p1;
#pragma unroll
                for (int i = 0; i < 16; ++i) { p0[i] = 0.f; p1[i] = 0.f; }
#pragma unroll
                for (int s = 0; s < 4; ++s) {
                    const bf16x8 a0 = *(const LAS bf16x8*)(Kb + r * KS_ + (16 * s + 8 * hh) * 2);
                    const bf16x8 a1 = *(const LAS bf16x8*)(Kb + (32 + r) * KS_ + (16 * s + 8 * hh) * 2);
                    p0 = MFMA32(a0, qf[s], p0); p1 = MFMA32(a1, qf[s], p1);
                }
                if (it == 0) sb_softcum<true>(p0, p1, R, 64 * kb + 4 * hh, qpos, hh);
                else sb_softcum<false>(p0, p1, R, 0, 0, hh);
                const bf16x8 pa00 = PACK_STEP(p0, 0), pa01 = PACK_STEP(p0, 1), pa10 = PACK_STEP(p1, 0), pa11 = PACK_STEP(p1, 1);
#pragma unroll
                for (int d = 0; d < 2; ++d) {
                    const LAS unsigned char* vr = Vb + (32 * d + r) * KS_;
                    const int sw = ((4 * d + (r >> 3)) & 7) << 3;
                    o[d] = MFMA32(pa00, cat4(*(const LAS s16x4*)(vr + ((0 + 4 * hh) ^ sw) * 2), *(const LAS s16x4*)(vr + ((8 + 4 * hh) ^ sw) * 2)), o[d]);
                    o[d] = MFMA32(pa01, cat4(*(const LAS s16x4*)(vr + ((16 + 4 * hh) ^ sw) * 2), *(const LAS s16x4*)(vr + ((24 + 4 * hh) ^ sw) * 2)), o[d]);
                    o[d] = MFMA32(pa10, cat4(*(const LAS s16x4*)(vr + ((32 + 4 * hh) ^ sw) * 2), *(const LAS s16x4*)(vr + ((40 + 4 * hh) ^ sw) * 2)), o[d]);
                    o[d] = MFMA32(pa11, cat4(*(const LAS s16x4*)(vr + ((48 + 4 * hh) ^ sw) * 2), *(const LAS s16x4*)(vr + ((56 + 4 * hh) ^ sw) * 2)), o[d]);
                }
            }
            { const int fw = it % 3;
              if (tid == 0) fl[(it + 1) % 3] = 0u;
              if (active && __any(R >= SB_STICK_EPS) && lane == 0) fl[fw] = 1u;
              if (it + 1 < nblk) ATT_STORE(buf ^ 1);
              __syncthreads();
              if (fl[fw] == 0u) break; }
        }
        if (active) {
#pragma unroll
            for (int d = 0; d < 2; ++d)
#pragma unroll
                for (int i = 0; i < 16; ++i) {
                    const int q = crow(i, hh);
                    const size_t orow = smp ? (size_t)MP + b * 32 + q : (size_t)b * 2048 + 64 * qb + 32 * (w & 1) + q;
                    const unsigned short ov = (unsigned short)(pk2(o[d][i], 0.f) & 0xffffu);
                    if constexpr (DRY) { asm volatile("" :: "v"(ov)); } else { QO[orow * 1024 + head * 64 + 32 * d + r] = ov; }
                }
        }
    }
#undef ATT_FETCH
#undef ATT_STORE
}

#define XB_TMO      128
#define XB_XCNT(j)  (256  + 64 * (j))
#define XB_XSUB(j)  (1280 + 64 * (j))
#define XB_XGEN(j)  (2304 + 64 * (j))
#define XB_TOP      3328
#define XB_TOPGEN   3392
#define XCD_BAR_WORDS 3456
#define XB_SPIN_CAP (1u << 18)

__device__ __forceinline__ unsigned xb_ld(unsigned* p)              { return __hip_atomic_load(p, __ATOMIC_RELAXED, __HIP_MEMORY_SCOPE_AGENT); }
__device__ __forceinline__ unsigned xb_add(unsigned* p, unsigned v) { return __hip_atomic_fetch_add(p, v, __ATOMIC_RELAXED, __HIP_MEMORY_SCOPE_AGENT); }
__device__ __forceinline__ unsigned xb_xcc_id() { return (unsigned)__builtin_amdgcn_s_getreg((3 << 11) | 20) & 0xFu; }
#define XB_SPIN(cond, bar) do { unsigned _sp = 0; while (cond) { __builtin_amdgcn_s_sleep(1); \
    if ((++_sp & 255u) == 0u) { if (xb_ld(&(bar)[XB_TMO])) break; if (_sp > XB_SPIN_CAP) { atomicAdd(&(bar)[XB_TMO], 1u); break; } } } } while (0)

struct XcdBarrier {
    unsigned* bar; unsigned x;
    volatile LAS unsigned* st;
};

__device__ __forceinline__ XcdBarrier xcd_barrier_post(unsigned* bar, volatile LAS unsigned* st) {
    XcdBarrier b; b.bar = bar; b.x = xb_xcc_id(); b.st = st;
    if (threadIdx.x == 0) (void)xb_add(&bar[XB_XCNT(b.x)], 1u);
    return b;
}
__device__ __forceinline__ void xcd_barrier_complete(unsigned* bar, unsigned x, unsigned& nloc, unsigned& nx) {
    const unsigned G = gridDim.x * gridDim.y * gridDim.z;
    unsigned sum, cnt, mine, sp = 0u;
    for (;;) {
        sum = 0u; cnt = 0u; mine = 0u;
#pragma unroll
        for (unsigned j = 0; j < 16; ++j) { const unsigned c = xb_ld(&bar[XB_XCNT(j)]); sum += c; cnt += (c > 0u) ? 1u : 0u; mine = (j == x) ? c : mine; }
        if (sum == G) break;
        __builtin_amdgcn_s_sleep(1);
        if ((++sp & 255u) == 0u) { if (xb_ld(&bar[XB_TMO])) break; if (sp > XB_SPIN_CAP) { atomicAdd(&bar[XB_TMO], 1u); break; } }
    }
    nloc = mine > 0u ? mine : 1u; nx = cnt > 0u ? cnt : 1u;
}

__device__ __forceinline__ void xcd_barrier(const XcdBarrier& b) {
    asm volatile("s_waitcnt vmcnt(0)" ::: "memory");
    __syncthreads();
    if (threadIdx.x == 0) {
        unsigned* bar = b.bar;
        __builtin_amdgcn_s_waitcnt(0);
        unsigned nloc = b.st[0], nx = b.st[1];
        if (nloc == 0u) { xcd_barrier_complete(bar, b.x, nloc, nx); b.st[0] = nloc; b.st[1] = nx; }
        const unsigned old = xb_add(&bar[XB_XSUB(b.x)], 1u);
        const unsigned gen = old / nloc;
        if (old + 1u == (gen + 1u) * nloc) {
            __builtin_amdgcn_fence(__ATOMIC_RELEASE, "agent");
            asm volatile("s_waitcnt vmcnt(0)" ::: "memory");
            const unsigned og = xb_add(&bar[XB_TOP], 1u);
            const unsigned tg = og / nx;
            if (og + 1u == (tg + 1u) * nx) xb_add(&bar[XB_TOPGEN], 1u);
            else XB_SPIN(xb_ld(&bar[XB_TOPGEN]) == tg, bar);
            __builtin_amdgcn_fence(__ATOMIC_ACQUIRE, "agent");
            xb_add(&bar[XB_XGEN(b.x)], 1u);
            asm volatile("s_waitcnt vmcnt(0)" ::: "memory");
        } else {
            XB_SPIN(xb_ld(&bar[XB_XGEN(b.x)]) == gen, bar);
            __builtin_amdgcn_fence(__ATOMIC_ACQUIRE, "agent");
            asm volatile("s_waitcnt vmcnt(0)" ::: "memory");
        }
    }
    __syncthreads();
}


constexpr int NPHASE = 18;
__global__ void __launch_bounds__(512, 2) mega_fwd(Prm P) {
    extern __shared__ __attribute__((aligned(16))) unsigned char lds_raw[];
    LAS unsigned char* lds = (LAS unsigned char*)lds_raw;
    cg::grid_group grid = cg::this_grid();
    const int G = gridDim.x, c = blockIdx.x;
    const bool TAILPROJ_ALL = (G == 256);
    volatile LAS unsigned* bst = (volatile LAS unsigned*)(lds + LDS_BYTES - 256);
    if (threadIdx.x < 2) bst[threadIdx.x] = 0u;
    __syncthreads();
#define PTRS unsigned char* ws = P.ws; asm volatile("" : "+s"(ws)); float* X = P.out; asm volatile("" : "+s"(X)); \
    float* ST = (float*)(ws + WS_ST); bf16_t* WT = (bf16_t*)(ws + WS_WT); bf16_t* XB = (bf16_t*)(ws + WS_XB); bf16_t* PB = (bf16_t*)(ws + WS_PB); \
    bf16_t* ACT = (bf16_t*)(ws + R_ACT); bf16_t* Zb = (bf16_t*)(ws + R_Z); bf16_t* XBC = (bf16_t*)(ws + R_XBC); bf16_t* QO = (bf16_t*)(ws + R_QO); \
    (void)ST; (void)WT; (void)XB; (void)PB; (void)ACT; (void)Zb; (void)XBC; (void)QO; (void)X;
#define ST_(k) (ST + (size_t)(k) * MA)
#define COMMA ,
#define SEAM(k) do { if ((k) + 1 < P.hi) { volatile LAS unsigned* bst_ = (volatile LAS unsigned*)(lds + LDS_BYTES - 256); \
        if ((k) == 0 || MK_CGSYNC) { grid.sync(); if ((k) == 0) (void)xcd_barrier_post((unsigned*)(P.ws + WS_BAR), bst_); } \
        else { XcdBarrier xb_; xb_.bar = (unsigned*)(P.ws + WS_BAR); xb_.x = xb_xcc_id(); xb_.st = bst_; xcd_barrier(xb_); } } } while (0)
#ifndef PH_MASK
#define PH_MASK 0x3ffff
#endif
#define IN(k) (((PH_MASK >> (k)) & 1) && P.lo <= (k) && (k) < P.hi)
#define GEMM_ON(EpiT, Aptr, Bptr, Nn, Kk, Eobj, Gx, cx) do { pg8::Gemm g_{(const bf16_t*)(Aptr), (const bf16_t*)(Bptr), MA, (Nn), (Kk)}; pg8::StaticOrder S_; S_.init(MA, (Nn), (Gx), (cx)); \
        pg8::gemm_phase<EpiT, pg8::StaticOrder, true, true>(lds, g_, S_, Eobj); } while (0)
#define GEMM(EpiT, Aptr, Bptr, Nn, Kk, Eobj) do { pg8::Gemm g_{(const bf16_t*)(Aptr), (const bf16_t*)(Bptr), MA, (Nn), (Kk)}; pg8::StaticOrder S_; S_.init(MA, (Nn), G, c); \
        pg8::gemm_phase<EpiT, pg8::StaticOrder, true, true>(lds, g_, S_, Eobj); } while (0)

#ifndef REAL2_MASK
#define REAL2_MASK 0
#endif
#define RUNPH(k, ...) do { if ((DRY_MASK >> (k)) & 1) { constexpr bool DRY = true; __VA_ARGS__ } if ((REAL2_MASK >> (k)) & 1) { constexpr bool DRY = false; __VA_ARGS__ } { constexpr bool DRY = false; __VA_ARGS__ } } while (0)
    if (IN(0)) { PTRS RUNPH(0, (void)DRY; p0_prologue<0>(P, lds, (int)blockIdx.x, G);); SEAM(0); }
    if (IN(1)) { PTRS RUNPH(1, pg8::EpiGU<DRY> E{ST_(0), ACT, 0, 0, X, ws}; GEMM(pg8::EpiGU<DRY>, XB, WT + O_GU00, 5632, 1024, E););
                if (G == 256 && c >= 88) p0_prologue<2>(P, lds, c - 88, 168); else if (G != 256) p0_prologue<2>(P, lds, c, G);
                SEAM(1); }
    if (IN(2)) { PTRS RUNPH(2, pg8::EpiRes<0 COMMA DRY> E{P.in[0], P.in[1], X, XB, ST_(1), 0.5f, nullptr, nullptr}; GEMM(pg8::EpiRes<0 COMMA DRY>, ACT, WT + O_D, 1024, 2816, E););
                 if (G == 256 && c >= 16) p0_prologue<1>(P, lds, c - 16, 240); else if (G != 256) p0_prologue<1>(P, lds, c, G);
                 SEAM(2); }
    if (IN(3)) { PTRS RUNPH(3, pg8::EpiIn<DRY> E{ST_(1), Zb, XBC, (float*)(ws + WS_DT)}; GEMM(pg8::EpiIn<DRY>, XB, WT + O_IN, NIN, 1024, E););
                if (G == 256 && c >= 84) p0_prologue<3>(P, lds, c - 84, 172); else if (G != 256) p0_prologue<3>(P, lds, c, G);
                SEAM(3); }
    if (IN(4)) { PTRS RUNPH(4, ssd_phase<DRY>(P, lds);); SEAM(4); }
    if (IN(5)) { PTRS RUNPH(5, pg8::EpiRes<2 COMMA DRY> E{X, X + (size_t)MP * 1024, X, XB, ST_(2), 1.0f, (const float*)(ws + WS_GST), nullptr}; GEMM(pg8::EpiRes<2 COMMA DRY>, Zb, WT + O_OUT, 1024, 2048, E););
                if (G == 256 && c >= 16) p0_prologue<4>(P, lds, c - 16, 240); else if (G != 256) p0_prologue<4>(P, lds, c, G);
                SEAM(5); }
    if (IN(6)) { PTRS RUNPH(6, pg8::EpiGU<DRY> E{ST_(2), ACT, 0, 0, X, ws}; GEMM(pg8::EpiGU<DRY>, XB, WT + O_GU01, 5632, 1024, E);); SEAM(6); }
    if (IN(7)) { PTRS RUNPH(7, pg8::EpiRes<0 COMMA DRY> E{X, X + (size_t)MP * 1024, X, XB, ST_(3), 0.5f, nullptr, nullptr}; GEMM(pg8::EpiRes<0 COMMA DRY>, ACT, WT + O_D + D_STRIDE, 1024, 2816, E););
                 if (TAILPROJ_ALL && c >= 16) { pg8::EpiProj<false> E{QO}; GEMM_ON(pg8::EpiProj<false>, PB, WT + O_PP0, 1024, 256, E, 240, c - 16); }
                 SEAM(7); }
    if (IN(8)) { PTRS
        RUNPH(8, if (!TAILPROJ_ALL) { pg8::EpiProj<DRY> E{QO}; GEMM(pg8::EpiProj<DRY>, PB, WT + O_PP0, 1024, 256, E); }
                 { pg8::EpiRes<1 COMMA DRY> E{X, X + (size_t)MP * 1024, X, QO, ST_(4), 1.0f, ST_(3), QO}; GEMM(pg8::EpiRes<1 COMMA DRY>, XB, WT + O_PG0, 1024, 1024, E); });
        SEAM(8); }
    if (IN(9)) { PTRS RUNPH(9, if (TAILPROJ_ALL) { pg8::EpiGU<DRY> E{ST_(4), ACT, 0, 0, X, ws}; GEMM(pg8::EpiGU<DRY>, QO, WT + O_GU10, 5632, 1024, E); }
                               else { pg8::EpiGU<DRY> E{ST_(4), ACT, 2, 0, X, ws}; GEMM(pg8::EpiGU<DRY>, QO, WT + O_KV, 6144, 1024, E); }); SEAM(9); }
    if (IN(10)) { PTRS RUNPH(10, pg8::EpiRes<0 COMMA DRY> E{X, X + (size_t)MP * 1024, X, XB, ST_(5), 0.5f, nullptr, nullptr}; GEMM(pg8::EpiRes<0 COMMA DRY>, ACT, WT + O_D + 2 * D_STRIDE, 1024, 2816, E););
                  if (TAILPROJ_ALL && c >= 16) { pg8::EpiGU<false> E{ST_(4), ACT, 2, 0, X, ws}; GEMM_ON(pg8::EpiGU<false>, QO, WT + O_KV, 512, 1024, E, 240, c - 16); }
                  SEAM(10); }
    if (IN(11)) { PTRS RUNPH(11, pg8::EpiQ<DRY> E{ST_(5), QO}; GEMM(pg8::EpiQ<DRY>, XB, WT + O_Q, 1024, 1024, E););
                  if (G == 256 && c >= 16) p0_prologue<5>(P, lds, c - 16, 240); else if (G != 256) p0_prologue<5>(P, lds, c, G);
                  SEAM(11); }
    if (IN(12)) { PTRS RUNPH(12, attn_phase<DRY>(P, lds);); SEAM(12); }
    if (IN(13)) { PTRS RUNPH(13, pg8::EpiRes<0 COMMA DRY> E{X, X + (size_t)MP * 1024, X, XB, ST_(6), 1.0f, nullptr, nullptr}; GEMM(pg8::EpiRes<0 COMMA DRY>, QO, WT + O_O, 1024, 1024, E););
                  if (G == 256 && c >= 16) p0_prologue<6>(P, lds, c - 16, 240); else if (G != 256) p0_prologue<6>(P, lds, c, G);
                  SEAM(13); }
    if (IN(14)) { PTRS RUNPH(14, pg8::EpiGU<DRY> E{ST_(6), ACT, 0, 0, X, ws}; GEMM(pg8::EpiGU<DRY>, XB, WT + O_GU11, 5632, 1024, E);); SEAM(14); }
    if (IN(15)) { PTRS RUNPH(15, pg8::EpiRes<0 COMMA DRY> E{X, X + (size_t)MP * 1024, X, XB, ST_(7), 0.5f, nullptr, nullptr}; GEMM(pg8::EpiRes<0 COMMA DRY>, ACT, WT + O_D + 3 * D_STRIDE, 1024, 2816, E););
                 if (TAILPROJ_ALL && c >= 16) { pg8::EpiProj<false> E{QO}; GEMM_ON(pg8::EpiProj<false>, PB + (size_t)MA * 256, WT + O_PP1, 1024, 256, E, 240, c - 16); }
                 SEAM(15); }
    if (IN(16)) { PTRS
        RUNPH(16, if (!TAILPROJ_ALL) { pg8::EpiProj<DRY> E{QO}; GEMM(pg8::EpiProj<DRY>, PB + (size_t)MA * 256, WT + O_PP1, 1024, 256, E); }
                  { pg8::EpiRes<1 COMMA DRY> E{X, X + (size_t)MP * 1024, X, nullptr, ST_(8), 1.0f, ST_(7), QO}; GEMM(pg8::EpiRes<1 COMMA DRY>, XB, WT + O_PG1, 1024, 1024, E); });
        SEAM(16); }
#ifdef EXTRA_SYNCS
    for (int i = 0; i < EXTRA_SYNCS; ++i) grid.sync();
#endif
    if (IN(17)) { PTRS final_norm_phase(P); }
}

extern "C" void kernel_launch(void* const* d_in, const int* in_sizes, int n_in, void* d_out, int out_size, void* d_ws, size_t ws_size, hipStream_t stream) {
    static int grid = 0;
    if (grid == 0) {
        if (n_in != 30 || ws_size < WS_END) { fprintf(stderr, "kernel_launch: unexpected n_in %d / ws_size %zu\n", n_in, ws_size); grid = -1; return; }
        int dev = 0, cus = 0, per_cu = 0;
        hipGetDevice(&dev); hipDeviceGetAttribute(&cus, hipDeviceAttributeMultiprocessorCount, dev);
        if (hipFuncSetAttribute((const void*)mega_fwd, hipFuncAttributeMaxDynamicSharedMemorySize, LDS_BYTES) != hipSuccess) { fprintf(stderr, "kernel_launch: hipFuncSetAttribute failed\n"); grid = -1; return; }
        if (hipOccupancyMaxActiveBlocksPerMultiprocessor(&per_cu, (const void*)mega_fwd, 512, LDS_BYTES) != hipSuccess || per_cu < 1) { fprintf(stderr, "kernel_launch: occupancy query %d\n", per_cu); per_cu = 1; }
        (void)hipGetLastError();
        grid = cus * 1;
    }
    if (grid < 0) return;
    Prm p{};
    for (int i = 0; i < 30; ++i) p.in[i] = (const float*)d_in[i];
    p.out = (float*)d_out; p.ws = (unsigned char*)d_ws;
#if MK_MULTI
    for (int ph = 0; ph < NPHASE; ++ph) { p.lo = ph; p.hi = ph + 1; void* args[] = {&p};
        hipError_t e = hipLaunchCooperativeKernel((const void*)mega_fwd, dim3(grid), dim3(512), args, LDS_BYTES, stream);
        if (e != hipSuccess) { fprintf(stderr, "launch %d failed: %s\n", ph, hipGetErrorString(e)); break; } }
#else
    p.lo = 0; p.hi = NPHASE; void* args[] = {&p};
    hipError_t e = hipLaunchCooperativeKernel((const void*)mega_fwd, dim3(grid), dim3(512), args, LDS_BYTES, stream);
    if (e != hipSuccess) fprintf(stderr, "cooperative launch failed: %s (grid %d)\n", hipGetErrorString(e), grid);
#endif
}
```

```cpp
#include <hip/hip_runtime.h>
#include <hip/hip_cooperative_groups.h>
#include <cstdio>
#include <cstdint>
namespace cg = cooperative_groups;

#ifndef MK_MULTI
#define MK_MULTI 0
#endif

constexpr int DM = 1024, MP = 65536, MS = 1024, MA = MP + MS;
constexpr int DFF = 2816, DIN = 2048, CONVD = 3072, NIN = 5376;
constexpr int SEQ = 2048, DSEQ = 32, PAST = 4096;
constexpr float EPS = 1e-6f;
constexpr size_t OFF_Y = 0, OFF_SSM_P = 68157440, OFF_CONV_P = 76546048, OFF_K_P = 76840960, OFF_V_P = 93618176,
                 OFF_SSM_S = 110395392, OFF_CONV_S = 118784000, OFF_K_S = 119078912, OFF_V_S = 119341056;
constexpr size_t MiB = 1u << 20;
constexpr size_t WS_ST = 0;
constexpr size_t WS_CNT = 3 * MiB;
constexpr size_t WS_WT = 4 * MiB;
constexpr size_t WS_XB = 100 * MiB;
constexpr size_t WS_PB = 230 * MiB;
constexpr size_t WS_R = 295 * MiB;
constexpr size_t R_ACT = WS_R, R_Z = WS_R, R_XBC = WS_R + 260 * MiB, R_QO = WS_R + 358 * MiB,
                 R_KP = WS_R + 488 * MiB, R_VP = WS_R + 520 * MiB, R_KSN = WS_R + 552 * MiB, R_VSN = WS_R + 553 * MiB;
constexpr size_t WS_DT = 945 * MiB;
constexpr size_t WS_END = 956 * MiB;
constexpr size_t O_GU00 = 0, O_GU01 = 5767168, O_KV = 11534336, O_GU10 = 12058624, O_GU11 = 17825792, O_D = 23592960,
                 O_IN = 35127296, O_OUT = 40632320, O_Q = 42729472, O_O = 43778048, O_PG0 = 44826624, O_PG1 = 45875200,
                 O_PP0 = 46923776, O_PP1 = 47185920;
constexpr size_t D_STRIDE = 2883584;

#define LAS __attribute__((address_space(3)))
typedef unsigned short bf16_t;
typedef short bf16x8 __attribute__((ext_vector_type(8)));
typedef short s16x4 __attribute__((ext_vector_type(4)));
typedef float f32x4 __attribute__((ext_vector_type(4)));
typedef float f32x16 __attribute__((ext_vector_type(16)));
typedef unsigned u32x4 __attribute__((ext_vector_type(4)));
typedef unsigned u32x2 __attribute__((ext_vector_type(2)));
typedef float f32x2_t __attribute__((ext_vector_type(2)));
typedef __bf16 bf16x2_t __attribute__((ext_vector_type(2)));
__device__ __forceinline__ unsigned pk2(float lo, float hi) { f32x2_t v = {lo, hi}; bf16x2_t b = __builtin_convertvector(v, bf16x2_t); return __builtin_bit_cast(unsigned, b); }
__device__ __forceinline__ float bf2f(unsigned short b) { return __uint_as_float(((unsigned)b) << 16); }
__device__ __forceinline__ float bflo(unsigned w) { return __uint_as_float(w << 16); }
__device__ __forceinline__ float bfhi(unsigned w) { return __uint_as_float(w & 0xffff0000u); }
__device__ __forceinline__ float fexp2(float x) { return __builtin_amdgcn_exp2f(x); }
__device__ __forceinline__ float flog2(float x) { return __builtin_amdgcn_logf(x); }
__device__ __forceinline__ float frcp(float x) { return __builtin_amdgcn_rcpf(x); }
__device__ __forceinline__ float fexp(float x) { return __builtin_amdgcn_exp2f(x * 1.4426950408889634f); }
__device__ __forceinline__ float sigmoidf_(float x) { return frcp(1.0f + fexp(-x)); }
__device__ __forceinline__ float siluf_(float x) { return x * sigmoidf_(x); }
__device__ __forceinline__ float rs_of(const float* st, int row) { return rsqrtf(st[row] * (1.0f / 1024.0f) + EPS); }
__device__ __forceinline__ int crow(int reg, int h) { return (reg & 3) + 8 * (reg >> 2) + 4 * h; }
#define MFMA32(a, b, c) __builtin_amdgcn_mfma_f32_32x32x16_bf16((a), (b), (c), 0, 0, 0)
__device__ __forceinline__ bf16x8 pack8(float a0, float a1, float a2, float a3, float a4, float a5, float a6, float a7) {
    u32x4 p; p.x = pk2(a0, a1); p.y = pk2(a2, a3); p.z = pk2(a4, a5); p.w = pk2(a6, a7); return __builtin_bit_cast(bf16x8, p);
}
#define PACK_STEP(x, s) pack8((x)[8 * (s)], (x)[8 * (s) + 1], (x)[8 * (s) + 2], (x)[8 * (s) + 3], (x)[8 * (s) + 4], (x)[8 * (s) + 5], (x)[8 * (s) + 6], (x)[8 * (s) + 7])
__device__ __forceinline__ bf16x8 cat4(s16x4 lo, s16x4 hi) { return __builtin_shufflevector(lo, hi, 0, 1, 2, 3, 4, 5, 6, 7); }

namespace pg8 {
#define PG8_LAS __attribute__((address_space(3)))
typedef unsigned short bf16_t;
typedef short bf16x8 __attribute__((ext_vector_type(8)));
typedef float f32x4 __attribute__((ext_vector_type(4)));
typedef unsigned u32x4 __attribute__((ext_vector_type(4)));
constexpr int BM = 256, BK = 64, HALF = 128, HTB = HALF * BK * 2  , STAGE_BYTES = 8 * HTB, NXCD = 8, WGM = 4;

__host__ __device__ __forceinline__ int lds_byte(int r, int c) { const int st = (r >> 4) * 2 + (c >> 5), rr = r & 15, cc = c & 31, ob = rr * 64 + cc * 2; return st * 1024 + (ob ^ (((ob >> 9) & 1) << 5)); }
__host__ __device__ __forceinline__ void stage_rc(int b, int& R, int& C) { const int st = b / 1024, sb = b % 1024, swz = sb ^ (((sb >> 9) & 1) << 5); R = (st >> 1) * 16 + swz / 64; C = (st & 1) * 32 + (swz % 64) / 2; }
__host__ __device__ __forceinline__ int perm32(int rho) { const int n = rho >> 4, i = rho & 15; return 8 * (i >> 2) + 4 * n + (i & 3); }

struct Unit { int pm, pn; };
struct Gemm { const bf16_t* A; const bf16_t* Bt; int M, N, K; };

struct StaticOrder {
    int nM, nN, nwg, G, c;
    __host__ __device__ void init(int M, int N, int G_, int c_) { nM = M / BM; nN = N / BM; nwg = nM * nN; G = G_; c = c_; }
    __host__ __device__ bool next(int i, Unit& u) const {
        const long L = (long)i * G + c; if (L >= nwg) return false;
        int wgid = (int)L; { const int q = nwg / NXCD, r = nwg % NXCD, xcd = wgid % NXCD, off = wgid / NXCD; wgid = (xcd < r ? xcd * (q + 1) : r * (q + 1) + (xcd - r) * q) + off; }
        const int nig = WGM * nN, gid = wgid / nig, fm = gid * WGM, gsz = (nM - fm) < WGM ? (nM - fm) : WGM;
        u.pm = fm + ((wgid % nig) % gsz); u.pn = (wgid % nig) / gsz; return true;
    }
    __device__ __forceinline__ void a_ready(const Unit&) const {}
    __device__ __forceinline__ void done(const Unit&) const {}
};

typedef unsigned u32x2 __attribute__((ext_vector_type(2)));
template <bool DRY, class T> __device__ __forceinline__ void stv(T* p, const T& v) { if constexpr (DRY) { asm volatile("" :: "v"(v)); } else { *p = v; } }
template <bool DRY, class T> __device__ __forceinline__ void stv_nt(T* p, const T& v) { if constexpr (DRY) { asm volatile("" :: "v"(v)); } else { __builtin_nontemporal_store(v, p); } }

template <bool DRY> struct EpiGU {
    static constexpr bool PERM = true, AFTER_DRAIN = false, KSEG = false;
    const float* st; bf16_t* act; int kv_tiles; int pad_; float* out; unsigned char* ws;
    __device__ __forceinline__ void operator()(const f32x4 (&acc)[2][2][4][2], const Unit& u, int wr, int wc, int fr, int fq) const {
        const int row0 = u.pm * BM + wr * 64 + fr;
        if (u.pn < kv_tiles) {
            const bool smp = u.pm >= 256;
            const size_t fo = u.pn == 0 ? (smp ? ::OFF_K_S : ::OFF_K_P) : (smp ? ::OFF_V_S : ::OFF_V_P);
            const size_t bo = u.pn == 0 ? (smp ? ::R_KSN : ::R_KP) : (smp ? ::R_VSN : ::R_VP);
            float* of = out + fo; bf16_t* ob = (bf16_t*)(ws + bo);
            const int rbase = smp ? 65536 : 0;
#pragma unroll
            for (int ai = 0; ai < 2; ++ai)
#pragma unroll
                for (int m = 0; m < 4; ++m) {
                    const int row = row0 + ai * HALF + m * 16; const float rs = ::rs_of(st, row); const size_t lr = (size_t)(row - rbase) * 256;
#pragma unroll
                    for (int bj = 0; bj < 2; ++bj) {
                        const int col = bj * HALF + wc * 32 + 8 * fq;
                        const f32x4 v0 = acc[ai][bj][m][0] * rs, v1 = acc[ai][bj][m][1] * rs;
                        stv<DRY>((f32x4*)(of + lr + col), v0); stv<DRY>((f32x4*)(of + lr + col + 4), v1);
                        u32x4 w; w.x = ::pk2(v0[0], v0[1]); w.y = ::pk2(v0[2], v0[3]); w.z = ::pk2(v1[0], v1[1]); w.w = ::pk2(v1[2], v1[3]);
                        stv<DRY>((u32x4*)(ob + lr + col), w);
                    }
                }
        } else {
            const int ct = u.pn - kv_tiles;
#pragma unroll
            for (int ai = 0; ai < 2; ++ai)
#pragma unroll
                for (int m = 0; m < 4; ++m) {
                    const int row = row0 + ai * HALF + m * 16; const float rs = ::rs_of(st, row);
                    const f32x4 g0 = acc[ai][0][m][0] * rs, g1 = acc[ai][0][m][1] * rs, u0 = acc[ai][1][m][0] * rs, u1 = acc[ai][1][m][1] * rs;
                    u32x4 w;
                    w.x = ::pk2(::siluf_(g0[0]) * u0[0], ::siluf_(g0[1]) * u0[1]); w.y = ::pk2(::siluf_(g0[2]) * u0[2], ::siluf_(g0[3]) * u0[3]);
                    w.z = ::pk2(::siluf_(g1[0]) * u1[0], ::siluf_(g1[1]) * u1[1]); w.w = ::pk2(::siluf_(g1[2]) * u1[2], ::siluf_(g1[3]) * u1[3]);
                    stv<DRY>((u32x4*)(act + (size_t)row * 2816 + ct * 128 + wc * 32 + 8 * fq), w);
                }
        }
    }
};

template <bool DRY> struct EpiQ {
    static constexpr bool PERM = true, AFTER_DRAIN = false, KSEG = false;
    const float* st; bf16_t* O;
    __device__ __forceinline__ void operator()(const f32x4 (&acc)[2][2][4][2], const Unit& u, int wr, int wc, int fr, int fq) const {
        const int row0 = u.pm * BM + wr * 64 + fr;
#pragma unroll
        for (int ai = 0; ai < 2; ++ai)
#pragma unroll
            for (int m = 0; m < 4; ++m) {
                const int row = row0 + ai * HALF + m * 16; const float rs = ::rs_of(st, row);
#pragma unroll
                for (int bj = 0; bj < 2; ++bj) {
                    const f32x4 v0 = acc[ai][bj][m][0] * rs, v1 = acc[ai][bj][m][1] * rs;
                    u32x4 w; w.x = ::pk2(v0[0], v0[1]); w.y = ::pk2(v0[2], v0[3]); w.z = ::pk2(v1[0], v1[1]); w.w = ::pk2(v1[2], v1[3]);
                    stv<DRY>((u32x4*)(O + (size_t)row * 1024 + u.pn * BM + bj * HALF + wc * 32 + 8 * fq), w);
                }
            }
    }
};

template <bool DRY> struct EpiIn {
    static constexpr bool PERM = true, AFTER_DRAIN = false, KSEG = false;
    const float* st; bf16_t* Z; bf16_t* XBC; float* DT;
    __device__ __forceinline__ void operator()(const f32x4 (&acc)[2][2][4][2], const Unit& u, int wr, int wc, int fr, int fq) const {
        const int row0 = u.pm * BM + wr * 64 + fr;
#pragma unroll
        for (int ai = 0; ai < 2; ++ai)
#pragma unroll
            for (int m = 0; m < 4; ++m) {
                const int row = row0 + ai * HALF + m * 16; const float rs = ::rs_of(st, row);
#pragma unroll
                for (int bj = 0; bj < 2; ++bj) {
                    const int cl = bj * HALF + wc * 32 + 8 * fq;
                    const f32x4 v0 = acc[ai][bj][m][0] * rs, v1 = acc[ai][bj][m][1] * rs;
                    if (u.pn < 20) {
                        u32x4 w; w.x = ::pk2(v0[0], v0[1]); w.y = ::pk2(v0[2], v0[3]); w.z = ::pk2(v1[0], v1[1]); w.w = ::pk2(v1[2], v1[3]);
                        bf16_t* dst = u.pn < 8 ? Z + (size_t)row * 2048 + u.pn * BM + cl : XBC + (size_t)row * 3072 + (u.pn - 8) * BM + cl;
                        stv<DRY>((u32x4*)dst, w);
                    } else if (cl < 32) {
                        stv<DRY>((f32x4*)(DT + (size_t)row * 32 + cl), v0); stv<DRY>((f32x4*)(DT + (size_t)row * 32 + cl + 4), v1);
                    }
                }
            }
    }
};

template <bool DRY> struct EpiProj {
    static constexpr bool PERM = false, AFTER_DRAIN = false, KSEG = false;
    bf16_t* P;
    __device__ __forceinline__ void operator()(const f32x4 (&acc)[2][2][4][2], const Unit& u, int wr, int wc, int fr, int fq) const {
        const int col0 = u.pn * BM + wc * 32 + 4 * fq;
#pragma unroll
        for (int ai = 0; ai < 2; ++ai)
#pragma unroll
            for (int m = 0; m < 4; ++m) {
                const size_t ro = (size_t)(u.pm * BM + ai * HALF + wr * 64 + m * 16 + fr) * 1024;
#pragma unroll
                for (int bj = 0; bj < 2; ++bj)
#pragma unroll
                    for (int n = 0; n < 2; ++n) { const f32x4 v = acc[ai][bj][m][n]; u32x2 w; w.x = ::pk2(v[0], v[1]); w.y = ::pk2(v[2], v[3]); stv<DRY>((u32x2*)(P + ro + col0 + bj * HALF + n * 16), w); }
            }
    }
};

__device__ __forceinline__ float grs_(const float* gst, int row, int g) { return rsqrtf(gst[(size_t)row * 4 + g] * (1.0f / 512.0f) + ::EPS); }
template <int MODE, bool DRY> struct EpiRes {
    static constexpr bool PERM = false, AFTER_DRAIN = false, KSEG = (MODE == 2);
    __device__ __forceinline__ void kscale(f32x4 (&acc)[2][2][4][2], const Unit& u, int seg, int wr, int wc, int fr, int fq) const {
        const int rowb = u.pm * BM + wr * 64 + fr;
#pragma unroll
        for (int ai = 0; ai < 2; ++ai)
#pragma unroll
            for (int m = 0; m < 4; ++m) {
                const int row = rowb + ai * HALF + m * 16;
                const float a = st_in[(size_t)row * 4 + seg - 1] * (1.0f / 512.0f) + ::EPS, b = st_in[(size_t)row * 4 + seg] * (1.0f / 512.0f) + ::EPS;
                const float ratio = sqrtf(b * ::frcp(a));
#pragma unroll
                for (int bj = 0; bj < 2; ++bj)
#pragma unroll
                    for (int n = 0; n < 2; ++n) acc[ai][bj][m][n] *= ratio;
            }
    }
    const float* res_p; const float* res_s; float* X; bf16_t* xb; float* st_out; float alpha; const float* st_in; const bf16_t* proj;
    __device__ __forceinline__ void operator()(const f32x4 (&acc)[2][2][4][2], const Unit& u, int wr, int wc, int fr, int fq) const {
        const int col0 = u.pn * BM + wc * 32 + 4 * fq;
        const float* rb = (u.pm < 256) ? res_p : res_s - (size_t)65536 * 1024;
        const int rowb = u.pm * BM + wr * 64 + fr;
        f32x4 rn[2][2]; u32x2 pn[2][2]; float rsn = 1.f;
        {   const size_t ro = (size_t)rowb * 1024;
#pragma unroll
            for (int bj = 0; bj < 2; ++bj)
#pragma unroll
                for (int n = 0; n < 2; ++n) { const int c = col0 + bj * HALF + n * 16; rn[bj][n] = *(const f32x4*)(rb + ro + c); if (MODE == 1) pn[bj][n] = *(const u32x2*)(proj + ro + c); }
            if (MODE == 1) rsn = ::rs_of(st_in, rowb); if (MODE == 2) rsn = grs_(st_in, rowb, 3);
        }
#pragma unroll
        for (int g = 0; g < 8; ++g) {
            const int ai = g >> 2, m = g & 3;
            const int row = rowb + ai * HALF + m * 16; const size_t ro = (size_t)row * 1024;
            f32x4 rc[2][2]; u32x2 pc[2][2]; const float rs = rsn;
#pragma unroll
            for (int bj = 0; bj < 2; ++bj)
#pragma unroll
                for (int n = 0; n < 2; ++n) { rc[bj][n] = rn[bj][n]; if (MODE == 1) pc[bj][n] = pn[bj][n]; }
            if (g < 7) {
                const int rown = rowb + ((g + 1) >> 2) * HALF + ((g + 1) & 3) * 16; const size_t ron = (size_t)rown * 1024;
#pragma unroll
                for (int bj = 0; bj < 2; ++bj)
#pragma unroll
                    for (int n = 0; n < 2; ++n) { const int c = col0 + bj * HALF + n * 16; rn[bj][n] = *(const f32x4*)(rb + ron + c); if (MODE == 1) pn[bj][n] = *(const u32x2*)(proj + ron + c); }
                if (MODE == 1) rsn = ::rs_of(st_in, rown); if (MODE == 2) rsn = grs_(st_in, rown, 3);
            }
            asm volatile("" ::: "memory");
            float ss = 0.f;
#pragma unroll
            for (int bj = 0; bj < 2; ++bj)
#pragma unroll
                for (int n = 0; n < 2; ++n) {
                    const int c = col0 + bj * HALF + n * 16;
                    const f32x4 r4 = rc[bj][n]; f32x4 v;
                    if (MODE == 0) v = r4 + acc[ai][bj][m][n] * alpha;
                    else if (MODE == 2) v = r4 + acc[ai][bj][m][n] * rs;
                    else { const u32x2 pw = pc[bj][n]; const f32x4 a = acc[ai][bj][m][n] * rs;
                           v[0] = r4[0] + ::sigmoidf_(a[0]) * ::bflo(pw.x); v[1] = r4[1] + ::sigmoidf_(a[1]) * ::bfhi(pw.x);
                           v[2] = r4[2] + ::sigmoidf_(a[2]) * ::bflo(pw.y); v[3] = r4[3] + ::sigmoidf_(a[3]) * ::bfhi(pw.y); }
                    ss += (v[0] * v[0] + v[1] * v[1]) + (v[2] * v[2] + v[3] * v[3]);
                    u32x2 w; w.x = ::pk2(v[0], v[1]); w.y = ::pk2(v[2], v[3]);
                    stv<DRY>((f32x4*)(X + ro + c), v); if (xb) stv<DRY>((u32x2*)(xb + ro + c), w);
                }
            ss += __shfl_xor(ss, 16); ss += __shfl_xor(ss, 32);
            if constexpr (DRY) { asm volatile("" :: "v"(ss)); } else { if (fq == 0) unsafeAtomicAdd(st_out + row, ss); }
            asm volatile("" ::: "memory");
        }
    }
};

template <class Epi, class Sched, bool ALIGN_EPI = false, bool SP2 = false>
__device__ __forceinline__ void gemm_phase(PG8_LAS unsigned char* lds, const Gemm g, const Sched& S, const Epi& E) {
    int tid_ = threadIdx.x; asm volatile("" : "+v"(tid_)); const int tid = tid_, wid = __builtin_amdgcn_readfirstlane(tid >> 6), lane = tid & 63, wr = wid >> 2, wc = wid & 3, fr = lane & 15, fq = lane >> 4;
    const int K = g.K, nt = K / BK;
    unsigned voffA[2], voffB[2];
#pragma unroll
    for (int i = 0; i < 2; ++i) { int R, C; stage_rc(tid * 16 + i * 8192, R, C); const int Rb = Epi::PERM ? ((R & ~31) + perm32(R & 31)) : R;
        voffA[i] = (unsigned)(R * K + C) * 2u; voffB[i] = (unsigned)(Rb * K + C) * 2u; }
    const size_t kstep = (size_t)(BK * 2);
    const size_t hstep = (size_t)HALF * K * 2;
    const size_t tstep = 2 * hstep;
    const unsigned ldsw = (unsigned)wid * 1024u;
    const int aoff = lds_byte(wr * 64 + fr, fq * 8), boff = lds_byte(wc * 32 + fr, fq * 8);
#define PG8_SA(b, h) (((b) * 2 + (h)) * HTB)
#define PG8_SB(b, h) ((4 + (b) * 2 + (h)) * HTB)
#define PG8_STAGE(bufoff, gbase, voff) do { _Pragma("unroll") for (int _i = 0; _i < 2; ++_i) \
        __builtin_amdgcn_global_load_lds((const unsigned*)((const char*)(gbase) + (voff)[_i]), (PG8_LAS unsigned*)(lds + (bufoff) + ldsw + _i * 8192), 16, 0, 0); } while (0)
#define PG8_LDA(dst, b, h) do { _Pragma("unroll") for (int m = 0; m < 4; ++m) _Pragma("unroll") for (int k = 0; k < 2; ++k) dst[m][k] = *(const PG8_LAS bf16x8*)(lds + PG8_SA(b, h) + aoff + m * 2048 + k * 1024); } while (0)
#define PG8_LDB(dst, b, h) do { _Pragma("unroll") for (int n = 0; n < 2; ++n) _Pragma("unroll") for (int k = 0; k < 2; ++k) dst[n][k] = *(const PG8_LAS bf16x8*)(lds + PG8_SB(b, h) + boff + n * 2048 + k * 1024); } while (0)
#define PG8_MMA(ai, bj, At, Bt) do { __builtin_amdgcn_s_setprio(1); _Pragma("unroll") for (int m = 0; m < 4; ++m) _Pragma("unroll") for (int n = 0; n < 2; ++n) _Pragma("unroll") for (int k = 0; k < 2; ++k) \
        acc[ai][bj][m][n] = __builtin_amdgcn_mfma_f32_16x16x32_bf16(Bt[n][k], At[m][k], acc[ai][bj][m][n], 0, 0, 0); __builtin_amdgcn_s_setprio(0); } while (0)
#define PG8_WAIT_V(n) asm volatile("s_waitcnt vmcnt(" #n ")" ::: "memory")
#define PG8_WAIT_L(n) asm volatile("s_waitcnt lgkmcnt(" #n ")" ::: "memory")
#define PG8_BAR __builtin_amdgcn_s_barrier()
#define PG8_SCHED __builtin_amdgcn_sched_barrier(0)
    Unit cur, nxt; int ui = 0;
    if (!S.next(0, cur)) return;
    f32x4 acc[2][2][4][2];
#pragma unroll
    for (int a = 0; a < 2; ++a)
#pragma unroll
        for (int b = 0; b < 2; ++b)
#pragma unroll
            for (int m = 0; m < 4; ++m)
#pragma unroll
                for (int n = 0; n < 2; ++n) acc[a][b][m][n] = (f32x4){0.f, 0.f, 0.f, 0.f};
    bf16x8 At[4][2], B0[2][2], B1[2][2];
    const char* cA = (const char*)g.A + (size_t)cur.pm * tstep; const char* cB = (const char*)g.Bt + (size_t)cur.pn * tstep;
    S.a_ready(cur);
    if constexpr (SP2) {
        PG8_STAGE(PG8_SB(0, 0), cB, voffB); PG8_STAGE(PG8_SB(0, 1), cB + hstep, voffB); PG8_STAGE(PG8_SA(0, 0), cA, voffA); PG8_STAGE(PG8_SA(0, 1), cA + hstep, voffA);
        if (wr == 1) PG8_BAR;
        PG8_WAIT_V(2); PG8_BAR;
        PG8_STAGE(PG8_SB(1, 0), cB + kstep, voffB); PG8_STAGE(PG8_SA(1, 0), cA + kstep, voffA); PG8_STAGE(PG8_SB(1, 1), cB + hstep + kstep, voffB);
        PG8_WAIT_V(6); PG8_BAR;
    } else {
        PG8_STAGE(PG8_SB(0, 0), cB, voffB); PG8_STAGE(PG8_SA(0, 0), cA, voffA); PG8_STAGE(PG8_SB(0, 1), cB + hstep, voffB); PG8_STAGE(PG8_SA(0, 1), cA + hstep, voffA);
        if (wr == 1) PG8_BAR;
        PG8_WAIT_V(4); PG8_BAR;
        PG8_STAGE(PG8_SB(1, 0), cB + kstep, voffB); PG8_STAGE(PG8_SA(1, 0), cA + kstep, voffA); PG8_STAGE(PG8_SB(1, 1), cB + hstep + kstep, voffB);
        PG8_WAIT_V(6); PG8_BAR;
    }
    for (;;) {
        const bool has_next = S.next(ui + 1, nxt);
        const char* nA = has_next ? (const char*)g.A + (size_t)nxt.pm * tstep : cA; const char* nB = has_next ? (const char*)g.Bt + (size_t)nxt.pn * tstep : cB;
        for (int t = 0; t < nt; t += 2) {
            const bool last = (t == nt - 2);
            const char* a1 = cA + (size_t)(t + 1) * kstep;
            const char* a2 = last ? nA : cA + (size_t)(t + 2) * kstep; const char* b2 = last ? nB : cB + (size_t)(t + 2) * kstep;
            const char* a3 = a2 + kstep; const char* b3 = b2 + kstep;
            if (last && has_next) S.a_ready(nxt);
            if constexpr (SP2) {
            PG8_LDB(B0, 0, 0); PG8_LDB(B1, 0, 1); PG8_SCHED; PG8_LDA(At, 0, 0); PG8_STAGE(PG8_SA(1, 1), a1 + hstep, voffA);
            PG8_WAIT_V(8); PG8_WAIT_L(0); PG8_BAR; PG8_MMA(0, 0, At, B0); PG8_MMA(0, 1, At, B1); PG8_BAR; PG8_SCHED;
            PG8_LDA(At, 0, 1); PG8_STAGE(PG8_SB(0, 0), b2, voffB); PG8_STAGE(PG8_SB(0, 1), b2 + hstep, voffB); PG8_STAGE(PG8_SA(0, 0), a2, voffA);
            PG8_WAIT_V(8); PG8_WAIT_L(0); PG8_BAR; PG8_MMA(1, 0, At, B0); PG8_MMA(1, 1, At, B1); PG8_BAR; PG8_SCHED;
            PG8_LDB(B0, 1, 0); PG8_LDB(B1, 1, 1); PG8_SCHED; PG8_LDA(At, 1, 0); PG8_STAGE(PG8_SA(0, 1), a2 + hstep, voffA);
            PG8_WAIT_V(8); PG8_WAIT_L(0); PG8_BAR; PG8_MMA(0, 0, At, B0); PG8_MMA(0, 1, At, B1); PG8_BAR; PG8_SCHED;
            PG8_LDA(At, 1, 1); PG8_STAGE(PG8_SB(1, 0), b3, voffB); PG8_STAGE(PG8_SB(1, 1), b3 + hstep, voffB); PG8_STAGE(PG8_SA(1, 0), a3, voffA);
            PG8_WAIT_V(8); PG8_WAIT_L(0); PG8_BAR; PG8_MMA(1, 0, At, B0); PG8_MMA(1, 1, At, B1); PG8_BAR; PG8_SCHED;
            } else {
            PG8_LDB(B0, 0, 0); PG8_SCHED; PG8_LDA(At, 0, 0); PG8_STAGE(PG8_SA(1, 1), a1 + hstep, voffA);
            PG8_WAIT_L(8); PG8_BAR; PG8_WAIT_L(0); PG8_MMA(0, 0, At, B0); PG8_BAR; PG8_SCHED;
            PG8_LDB(B1, 0, 1); PG8_STAGE(PG8_SB(0, 0), b2, voffB);
            PG8_BAR; PG8_WAIT_L(0); PG8_MMA(0, 1, At, B1); PG8_BAR;
            PG8_LDA(At, 0, 1); PG8_STAGE(PG8_SA(0, 0), a2, voffA);
            PG8_BAR; PG8_WAIT_L(0); PG8_MMA(1, 0, At, B0); PG8_BAR; PG8_SCHED;
            PG8_STAGE(PG8_SB(0, 1), b2 + hstep, voffB);
            PG8_WAIT_V(6); PG8_BAR; PG8_MMA(1, 1, At, B1); PG8_BAR;
            PG8_LDB(B0, 1, 0); PG8_SCHED; PG8_LDA(At, 1, 0); PG8_STAGE(PG8_SA(0, 1), a2 + hstep, voffA);
            PG8_WAIT_L(8); PG8_BAR; PG8_WAIT_L(0); PG8_MMA(0, 0, At, B0); PG8_BAR; PG8_SCHED;
            PG8_LDB(B1, 1, 1); PG8_STAGE(PG8_SB(1, 0), b3, voffB);
            PG8_BAR; PG8_WAIT_L(0); PG8_MMA(0, 1, At, B1); PG8_BAR;
            PG8_LDA(At, 1, 1); PG8_STAGE(PG8_SA(1, 0), a3, voffA);
            PG8_BAR; PG8_WAIT_L(0); PG8_MMA(1, 0, At, B0); PG8_BAR; PG8_SCHED;
            PG8_STAGE(PG8_SB(1, 1), b3 + hstep, voffB);
            PG8_WAIT_V(6); PG8_BAR; PG8_MMA(1, 1, At, B1); PG8_BAR;
            }
            if constexpr (Epi::KSEG) { if (((t + 2) & 7) == 0 && t + 2 < nt) E.kscale(acc, cur, (t + 2) >> 3, wr, wc, fr, fq); }
        }
        if constexpr (ALIGN_EPI) { if (wr == 0) PG8_BAR; }
        if constexpr (!Epi::AFTER_DRAIN) { E(acc, cur, wr, wc, fr, fq); S.done(cur); }
        if (!has_next) break;
#pragma unroll
        for (int a = 0; a < 2; ++a)
#pragma unroll
            for (int b = 0; b < 2; ++b)
#pragma unroll
                for (int m = 0; m < 4; ++m)
#pragma unroll
                    for (int n = 0; n < 2; ++n) acc[a][b][m][n] = (f32x4){0.f, 0.f, 0.f, 0.f};
        cur = nxt; cA = nA; cB = nB; ++ui;
        if constexpr (ALIGN_EPI) { if (wr == 1) PG8_BAR; }
    }
    PG8_WAIT_V(0);
    if constexpr (!ALIGN_EPI) { if (wr == 0) PG8_BAR; }
    PG8_BAR;
    if constexpr (Epi::AFTER_DRAIN) { E.fused(acc, cur, wr, wc, fr, fq, lds, wid, lane); S.done(cur); }
#undef PG8_SA
#undef PG8_SB
#undef PG8_STAGE
#undef PG8_LDA
#undef PG8_LDB
#undef PG8_MMA
#undef PG8_WAIT_V
#undef PG8_WAIT_L
#undef PG8_BAR
#undef PG8_SCHED
}
}

constexpr int LDS_BYTES = 155648;
struct Prm { const float* in[30]; float* out; unsigned char* ws; int lo, hi; };
#ifndef DRY_MASK
#define DRY_MASK 0
#endif
#ifndef MK_CGSYNC
#define MK_CGSYNC 0
#endif
constexpr size_t WS_BAR = 3 * MiB + 65536;
constexpr size_t WS_GST = 954 * MiB;

#define LDS_WAIT() asm volatile("s_waitcnt lgkmcnt(0)" ::: "memory")

__device__ __forceinline__ float wave_sum(float v) {
#pragma unroll
    for (int o = 1; o < 64; o <<= 1) v += __shfl_xor(v, o);
    return v;
}

__device__ __forceinline__ void tr_item(const float* __restrict__ W, int K, int N, const float* __restrict__ gain, float gs, bf16_t* WT, int drow0, int k0, int n0, LAS float* scr, int lane) {
#pragma unroll 8
    for (int i = 0; i < 32; ++i) { const int kk = 2 * i + (lane >> 5); const float g = gain ? gain[k0 + kk] * gs : gs; scr[kk * 33 + (lane & 31)] = __builtin_nontemporal_load(&W[(size_t)(k0 + kk) * N + n0 + (lane & 31)]) * g; }
    LDS_WAIT();
    const int c = lane & 7;
#pragma unroll
    for (int j = 0; j < 4; ++j) { const int n = (lane >> 3) + 8 * j; const LAS float* s = scr + (8 * c) * 33 + n;
        u32x4 o; o.x = pk2(s[0 * 33], s[1 * 33]); o.y = pk2(s[2 * 33], s[3 * 33]); o.z = pk2(s[4 * 33], s[5 * 33]); o.w = pk2(s[6 * 33], s[7 * 33]);
        *(u32x4*)(WT + (size_t)(drow0 + n) * K + k0 + 8 * c) = o; }
    LDS_WAIT();
}
template <int MODE>
__device__ __forceinline__ void tr_job(const float* W, int K, int N, const float* gain, float gs, bf16_t* WT, int row_off, LAS float* scr, int gw, int ngw, int lane) {
    const int nblk = N / 32, nitems = (K / 64) * nblk;
    for (int it = gw; it < nitems; it += ngw) {
        const int kb = it / nblk, nb = it - kb * nblk, n0 = nb * 32;
        const int drow0 = (MODE == 1 ? 256 * (n0 >> 7) + (n0 & 127) : n0) + row_off;
        tr_item(W, K, N, gain, gs, WT, drow0, kb * 64, n0, scr, lane);
    }
}

template <int PART> __device__ __forceinline__ void p0_prologue(const Prm& P, LAS unsigned char* lds, const int blk, const int nblk) {
    int tid_ = threadIdx.x; asm volatile("" : "+v"(tid_)); const int tid = tid_, lane = tid & 63, wave = tid >> 6;
    const int gw = blk * 8 + wave, ngw = nblk * 8;
    LAS float* scr = (LAS float*)(lds + wave * 16384);
    bf16_t* WT = (bf16_t*)(P.ws + WS_WT);
    float* ST = (float*)(P.ws + WS_ST);
#pragma unroll
    for (int l = 0; l < 4; ++l) {
        const size_t ogu = l == 0 ? O_GU00 : l == 1 ? O_GU01 : l == 2 ? O_GU10 : O_GU11;
        const float* gain = P.in[8] + l * 1024;
        const bool gu_here = (l == 0 && PART == 0) || (l == 1 && PART == 3) || (l >= 2 && PART == 1);
        const bool d_here = (l == 0 && PART == 2) || (l == 1 && PART == 4) || (l >= 2 && PART == 1);
        if (gu_here) {
        tr_job<1>(P.in[9] + (size_t)l * D_STRIDE, 1024, 2816, gain, 1.f, WT + ogu, 0, scr, gw, ngw, lane);
        tr_job<1>(P.in[10] + (size_t)l * D_STRIDE, 1024, 2816, gain, 1.f, WT + ogu, 128, scr, gw, ngw, lane);
        }
        if (d_here) tr_job<0>(P.in[11] + (size_t)l * D_STRIDE, 2816, 1024, nullptr, 1.f, WT + O_D + (size_t)l * D_STRIDE, 0, scr, gw, ngw, lane);
    }
    if (PART == 2) {
    tr_job<0>(P.in[13], 1024, 5152, P.in[12], 1.f, WT + O_IN, 0, scr, gw, ngw, lane);
    { u32x4* z = (u32x4*)(WT + O_IN + (size_t)5152 * 1024); const int n16 = 224 * 1024 / 8; const u32x4 zz = {0u, 0u, 0u, 0u};
      for (int i = blk * 512 + tid; i < n16; i += nblk * 512) z[i] = zz; }
    }
    if (PART == 3) {
    tr_job<0>(P.in[20], 2048, 1024, P.in[19], 1.f, WT + O_OUT, 0, scr, gw, ngw, lane);
    }
    if (PART == 1) {
    tr_job<0>(P.in[22], 1024, 256, P.in[21], 1.f, WT + O_KV, 0, scr, gw, ngw, lane);
    tr_job<0>(P.in[23], 1024, 256, P.in[21], 1.f, WT + O_KV, 256, scr, gw, ngw, lane);
    tr_job<0>(P.in[24], 1024, 1024, P.in[12] + 1024, 0.125f * 1.4426950408889634f, WT + O_Q, 0, scr, gw, ngw, lane);
    tr_job<0>(P.in[25], 1024, 1024, nullptr, 1.f, WT + O_O, 0, scr, gw, ngw, lane);
    tr_job<0>(P.in[27], 1024, 1024, P.in[26], 1.f, WT + O_PG0, 0, scr, gw, ngw, lane);
    tr_job<0>(P.in[27] + 1048576, 1024, 1024, P.in[26] + 1024, 1.f, WT + O_PG1, 0, scr, gw, ngw, lane);
    tr_job<0>(P.in[28], 256, 1024, nullptr, 1.f, WT + O_PP0, 0, scr, gw, ngw, lane);
    tr_job<0>(P.in[28] + 262144, 256, 1024, nullptr, 1.f, WT + O_PP1, 0, scr, gw, ngw, lane);
    }
    if (PART == 0) {
    { float* z = ST + MA; for (int i = blk * 512 + tid; i < 8 * MA; i += nblk * 512) z[i] = 0.f;
      float* zg = (float*)(P.ws + WS_GST); for (int i = blk * 512 + tid; i < 4 * MA; i += nblk * 512) zg[i] = 0.f;
      if (blk == 0 && tid < 64) ((unsigned*)(P.ws + WS_CNT))[tid] = 0u;
      if (blk == 1) for (int i = tid; i < 3456; i += 512) ((unsigned*)(P.ws + WS_BAR))[i] = 0u; }
    bf16_t* XB = (bf16_t*)(P.ws + WS_XB);
    for (int row = gw; row < MA; row += 2 * ngw) {
        const int row2 = row + ngw; const bool has2 = row2 < MA; const int r2 = has2 ? row2 : row;
        const float* xr = row < MP ? P.in[0] + (size_t)row * 1024 : P.in[1] + (size_t)(row - MP) * 1024;
        const float* xr2 = r2 < MP ? P.in[0] + (size_t)r2 * 1024 : P.in[1] + (size_t)(r2 - MP) * 1024;
        f32x4 v[4], w[4];
#pragma unroll
        for (int j = 0; j < 4; ++j) v[j] = __builtin_nontemporal_load((const f32x4*)(xr + 256 * j + 4 * lane));
#pragma unroll
        for (int j = 0; j < 4; ++j) w[j] = __builtin_nontemporal_load((const f32x4*)(xr2 + 256 * j + 4 * lane));
        float s = 0.f, s2 = 0.f;
#pragma unroll
        for (int j = 0; j < 4; ++j) { s += (v[j][0] * v[j][0] + v[j][1] * v[j][1]) + (v[j][2] * v[j][2] + v[j][3] * v[j][3]);
            u32x2 o; o.x = pk2(v[j][0], v[j][1]); o.y = pk2(v[j][2], v[j][3]); *(u32x2*)(XB + (size_t)row * 1024 + 256 * j + 4 * lane) = o; }
        s = wave_sum(s);
        if (lane == 0) ST[row] = s;
        if (has2) {
#pragma unroll
            for (int j = 0; j < 4; ++j) { s2 += (w[j][0] * w[j][0] + w[j][1] * w[j][1]) + (w[j][2] * w[j][2] + w[j][3] * w[j][3]);
                u32x2 o; o.x = pk2(w[j][0], w[j][1]); o.y = pk2(w[j][2], w[j][3]); *(u32x2*)(XB + (size_t)row2 * 1024 + 256 * j + 4 * lane) = o; }
            s2 = wave_sum(s2);
            if (lane == 0) ST[row2] = s2;
        }
    }
    }
    if (PART >= 4) {
    bf16_t* PB = (bf16_t*)(P.ws + WS_PB);
    const int r_lo = PART == 4 ? 0 : (PART == 5 ? MA : MA + MA / 2), r_hi = PART == 4 ? MA : (PART == 5 ? MA + MA / 2 : 2 * MA);
    for (int r2 = r_lo + gw; r2 < r_hi; r2 += ngw) {
        const int l = r2 >= MA ? 1 : 0, row = r2 - l * MA;
        const float* pr = row < MP ? P.in[2] + ((size_t)l * MP + row) * 256 : P.in[3] + ((size_t)l * MS + (row - MP)) * 256;
        const f32x4 v = __builtin_nontemporal_load((const f32x4*)(pr + 4 * lane));
        u32x2 w; w.x = pk2(v[0], v[1]); w.y = pk2(v[2], v[3]); *(u32x2*)(PB + (size_t)r2 * 256 + 4 * lane) = w;
    }
    }
}

__device__ __forceinline__ void final_norm_phase(const Prm& P) {
    int tid_ = threadIdx.x; asm volatile("" : "+v"(tid_)); const int tid = tid_, lane = tid & 63, wave = tid >> 6;
    const int gw = blockIdx.x * 8 + wave, ngw = gridDim.x * 8;
    const float* st = (const float*)(P.ws + WS_ST) + (size_t)8 * MA; const float* g = P.in[29];
    f32x4 gg[4];
#pragma unroll
    for (int j = 0; j < 4; ++j) gg[j] = *(const f32x4*)(g + 256 * j + 4 * lane);
    for (int row = gw; row < MA; row += 2 * ngw) {
        const int row2 = row + ngw; const bool has2 = row2 < MA;
        float* xr = P.out + (size_t)row * 1024; float* xr2 = P.out + (size_t)(has2 ? row2 : row) * 1024;
        f32x4 v[4], w[4];
#pragma unroll
        for (int j = 0; j < 4; ++j) v[j] = *(const f32x4*)(xr + 256 * j + 4 * lane);
#pragma unroll
        for (int j = 0; j < 4; ++j) w[j] = *(const f32x4*)(xr2 + 256 * j + 4 * lane);
        const float rs = rs_of(st, row), rs2 = rs_of(st, has2 ? row2 : row);
#pragma unroll
        for (int j = 0; j < 4; ++j) *(f32x4*)(xr + 256 * j + 4 * lane) = v[j] * rs * gg[j];
        if (has2) {
#pragma unroll
            for (int j = 0; j < 4; ++j) *(f32x4*)(xr2 + 256 * j + 4 * lane) = w[j] * rs2 * gg[j];
        }
    }
}

constexpr int SS_CM = 0, SS_BM = 8704, SS_BT = 17408, SS_X0 = 27648, SS_X2 = 48128, SS_ZS = 68608, SS_DTV = 85504, SS_ACS = 86528;
constexpr int CMS = 272, BTS = 80, XS = 80, ZSS = 528;

template <bool DRY> __device__ __forceinline__ void ssd_phase(const Prm& P, LAS unsigned char* lds) {
    int tid_ = threadIdx.x; asm volatile("" : "+v"(tid_)); const int tid0 = tid_;
    bf16_t* Zb = (bf16_t*)(P.ws + R_Z); const bf16_t* XBC = (const bf16_t*)(P.ws + R_XBC); const float* DT = (const float*)(P.ws + WS_DT);
    float* GST = (float*)(P.ws + WS_GST);
    const float* conv_w = P.in[14]; const float* conv_b = P.in[15]; const float* dt_bias = P.in[16]; const float* a_log = P.in[17]; const float* dskip = P.in[18];
    for (int unit = blockIdx.x; unit < 512; unit += gridDim.x) {
        const bool smp = unit >= 256; const int uu = unit & 255, b = uu >> 3, g = (uu >> 1) & 3, hf = uu & 1;
        const int L = smp ? DSEQ : SEQ, nch = L / 32; const size_t row_base = smp ? (size_t)MP + b * 32 : (size_t)b * 2048;
        int tidu = tid0; asm volatile("" : "+v"(tidu));
        const int head = g * 8 + hf * 4 + (tidu >> 7);
        float* so = P.out + (smp ? OFF_SSM_S : OFF_SSM_P) + ((size_t)(b * 32 + head) * 64) * 128;
        f32x16 ST[4];
        { const int r = tidu & 31, hh = (tidu >> 5) & 1, ph = (tidu >> 6) & 1;
#pragma unroll
        for (int nt = 0; nt < 4; ++nt) {
                if (smp) { const float* si = P.in[4] + ((size_t)(b * 32 + head) * 64) * 128;
#pragma unroll
                    for (int q = 0; q < 4; ++q) { const f32x4 v = *(const f32x4*)(si + (size_t)(32 * ph + r) * 128 + 32 * nt + 8 * q + 4 * hh);
                        ST[nt][4 * q] = v[0]; ST[nt][4 * q + 1] = v[1]; ST[nt][4 * q + 2] = v[2]; ST[nt][4 * q + 3] = v[3]; }
                } else {
#pragma unroll
                    for (int i = 0; i < 16; ++i) ST[nt][i] = 0.f;
                }
            }
        }
        const float Dh = dskip[head];
        float dtr = 0.f;
        if (tidu < 128) dtr = DT[(row_base + (tidu & 31)) * 32 + g * 8 + hf * 4 + (tidu >> 5)];
        float cw[2][2][5]; unsigned raw[2][11]; u32x4 zreg[2];
        {
            const bf16_t* xb0 = XBC + row_base * 3072;
#pragma unroll
            for (int k = 0; k < 2; ++k) {
                const int idx = tidu + 512 * k, pr = idx & 255, q = idx >> 8, lc = 2 * pr;
                const int gc = lc < 256 ? g * 512 + hf * 256 + lc : (lc < 384 ? 2048 + g * 128 + (lc - 256) : 2560 + g * 128 + (lc - 384));
#pragma unroll
                for (int c2 = 0; c2 < 2; ++c2) { cw[k][c2][0] = conv_w[gc + c2]; cw[k][c2][1] = conv_w[3072 + gc + c2]; cw[k][c2][2] = conv_w[2 * 3072 + gc + c2]; cw[k][c2][3] = conv_w[3 * 3072 + gc + c2]; cw[k][c2][4] = conv_b[gc + c2]; }
#pragma unroll
                for (int i = 0; i < 11; ++i) raw[k][i] = *(const unsigned*)(xb0 + (8 * q - 3 + i) * 3072 + gc);
                const int zr = idx >> 5, c16 = idx & 31;
                zreg[k] = *(const u32x4*)(Zb + (row_base + zr) * 2048 + g * 512 + hf * 256 + c16 * 8);
            }
        }
#define SSD_STAGE0(CH, TID) do { if ((TID) < 128) { const int h4_ = (TID) >> 5, j_ = (TID) & 31, hd_ = g * 8 + hf * 4 + h4_; \
            const float v_ = dtr + dt_bias[hd_]; \
            if ((CH) + 1 < nch) dtr = DT[(row_base + ((CH) + 1) * 32 + j_) * 32 + hd_]; \
            const float dt_ = v_ > 20.f ? v_ : 0.6931471805599453f * flog2(1.0f + fexp(v_)); \
            float acs_ = dt_ * (-fexp(a_log[hd_])); \
            _Pragma("unroll") for (int o_ = 1; o_ < 32; o_ <<= 1) { const float t_ = __shfl_up(acs_, o_, 32); if (j_ >= o_) acs_ += t_; } \
            ((LAS float*)(lds + SS_DTV))[((CH) & 1) * 128 + h4_ * 32 + j_] = dt_; ((LAS float*)(lds + SS_ACS))[((CH) & 1) * 128 + h4_ * 32 + j_] = acs_; } } while (0)
        __syncthreads();
        SSD_STAGE0(0, tidu);
        for (int ch = 0; ch < nch; ++ch) {
            const int t0 = ch * 32;
            int tidc = tid0; asm volatile("" : "+v"(tidc));
            const int tid = tidc, lane = tid & 63, wv = tid >> 6, hw = wv >> 1, ph = wv & 1, r = lane & 31, hh = lane >> 5;
            LAS float* DTV = (LAS float*)(lds + SS_DTV) + (ch & 1) * 128; LAS float* ACS = (LAS float*)(lds + SS_ACS) + (ch & 1) * 128;
            __syncthreads();
            {
            const bf16_t* xbase = XBC + (row_base + t0) * 3072;
            const float* scbase = P.in[5] + (size_t)b * 3 * 3072;
#pragma unroll
            for (int k = 0; k < 2; ++k) {
                const int idx = tid + 512 * k, pr = idx & 255, q = idx >> 8, lc = 2 * pr;
                const int gc = lc < 256 ? g * 512 + hf * 256 + lc : (lc < 384 ? 2048 + g * 128 + (lc - 256) : 2560 + g * 128 + (lc - 384));
                if (t0 == 0) {
                    unsigned f0 = 0u, f1 = 0u, f2 = 0u;
                    if (smp) { f0 = pk2(scbase[gc], scbase[gc + 1]); f1 = pk2(scbase[3072 + gc], scbase[3072 + gc + 1]); f2 = pk2(scbase[2 * 3072 + gc], scbase[2 * 3072 + gc + 1]); }
                    if (q == 0) { raw[k][0] = f0; raw[k][1] = f1; raw[k][2] = f2; }
                }
                unsigned oa[4], ob[4];
                float fa[8], fb[8];
#pragma unroll
                for (int i = 0; i < 8; ++i) fa[i] = siluf_(cw[k][0][4] + cw[k][0][0] * bflo(raw[k][i]) + cw[k][0][1] * bflo(raw[k][i + 1]) + cw[k][0][2] * bflo(raw[k][i + 2]) + cw[k][0][3] * bflo(raw[k][i + 3]));
#pragma unroll
                for (int i = 0; i < 8; ++i) fb[i] = siluf_(cw[k][1][4] + cw[k][1][0] * bfhi(raw[k][i]) + cw[k][1][1] * bfhi(raw[k][i + 1]) + cw[k][1][2] * bfhi(raw[k][i + 2]) + cw[k][1][3] * bfhi(raw[k][i + 3]));
#pragma unroll
                for (int i = 0; i < 4; ++i) { oa[i] = pk2(fa[2 * i], fa[2 * i + 1]); ob[i] = pk2(fb[2 * i], fb[2 * i + 1]); }
                if (lc < 256) {
                    const int h4 = lc >> 6, p = lc & 63; const float aend = ACS[h4 * 32 + 31];
                    *(LAS u32x4*)(lds + SS_X0 + (h4 * 64 + p) * XS + 16 * q) = (u32x4){oa[0], oa[1], oa[2], oa[3]};
                    *(LAS u32x4*)(lds + SS_X0 + (h4 * 64 + p + 1) * XS + 16 * q) = (u32x4){ob[0], ob[1], ob[2], ob[3]};
#pragma unroll
                    for (int i = 0; i < 8; ++i) { const int j = 8 * q + i; const float f = DTV[h4 * 32 + j] * fexp(aend - ACS[h4 * 32 + j]); fa[i] *= f; fb[i] *= f; }
#pragma unroll
                    for (int i = 0; i < 4; ++i) { oa[i] = pk2(fa[2 * i], fa[2 * i + 1]); ob[i] = pk2(fb[2 * i], fb[2 * i + 1]); }
                    *(LAS u32x4*)(lds + SS_X2 + (h4 * 64 + p) * XS + 16 * q) = (u32x4){oa[0], oa[1], oa[2], oa[3]};
                    *(LAS u32x4*)(lds + SS_X2 + (h4 * 64 + p + 1) * XS + 16 * q) = (u32x4){ob[0], ob[1], ob[2], ob[3]};
                } else {
                    const int n = lc < 384 ? lc - 256 : lc - 384; const int rowbase = lc < 384 ? SS_BM : SS_CM;
#pragma unroll
                    for (int i = 0; i < 8; ++i) *(LAS unsigned*)(lds + rowbase + (8 * q + i) * CMS + n * 2) = pk2(fa[i], fb[i]);
                    if (lc < 384) {
                        *(LAS u32x4*)(lds + SS_BT + n * BTS + 16 * q) = (u32x4){oa[0], oa[1], oa[2], oa[3]};
                        *(LAS u32x4*)(lds + SS_BT + (n + 1) * BTS + 16 * q) = (u32x4){ob[0], ob[1], ob[2], ob[3]};
                    }
                }
            }
#pragma unroll
            for (int k = 0; k < 2; ++k) { const int idx = tid + 512 * k, zr = idx >> 5, c16 = idx & 31; *(LAS u32x4*)(lds + SS_ZS + zr * ZSS + c16 * 16) = zreg[k]; }
            if (ch + 1 < nch) {
#pragma unroll
                for (int k = 0; k < 2; ++k) {
                    const int idx = tid + 512 * k, pr = idx & 255, q = idx >> 8, lc = 2 * pr;
                    const int gc = lc < 256 ? g * 512 + hf * 256 + lc : (lc < 384 ? 2048 + g * 128 + (lc - 256) : 2560 + g * 128 + (lc - 384));
#pragma unroll
                    for (int i = 0; i < 11; ++i) raw[k][i] = *(const unsigned*)(xbase + (32 + 8 * q - 3 + i) * 3072 + gc);
                    const int zr = idx >> 5, c16 = idx & 31;
                    zreg[k] = *(const u32x4*)(Zb + (row_base + t0 + 32 + zr) * 2048 + g * 512 + hf * 256 + c16 * 8);
                }
            }
            }
            __syncthreads();
            {
                const float acs_i = ACS[hw * 32 + r];
                f32x16 gt;
#pragma unroll
                for (int i = 0; i < 16; ++i) gt[i] = 0.f;
#pragma unroll
                for (int s = 0; s < 8; ++s) {
                    const bf16x8 a = *(const LAS bf16x8*)(lds + SS_BM + r * CMS + (16 * s + 8 * hh) * 2);
                    const bf16x8 bq = *(const LAS bf16x8*)(lds + SS_CM + r * CMS + (16 * s + 8 * hh) * 2);
                    gt = MFMA32(a, bq, gt);
                }
#pragma unroll
                for (int i = 0; i < 16; ++i) { const int j = crow(i, hh); const float aj = ACS[hw * 32 + j], dj = DTV[hw * 32 + j];
                    gt[i] = (j <= r) ? gt[i] * fexp(acs_i - aj) * dj : 0.f; }
                const bf16x8 ga0 = PACK_STEP(gt, 0), ga1 = PACK_STEP(gt, 1);
                __builtin_amdgcn_sched_barrier(0);
                f32x16 y;
#pragma unroll
                for (int i = 0; i < 16; ++i) y[i] = 0.f;
                const int xrow = (hw * 64 + 32 * ph + r) * XS;
#pragma unroll
                for (int nt = 0; nt < 4; ++nt)
#pragma unroll
                    for (int s = 0; s < 2; ++s) {
                        const s16x4 lo = *(const LAS s16x4*)(lds + SS_CM + r * CMS + (32 * nt + 16 * s + 4 * hh) * 2);
                        const s16x4 hi = *(const LAS s16x4*)(lds + SS_CM + r * CMS + (32 * nt + 16 * s + 8 + 4 * hh) * 2);
                        const bf16x8 sb = s == 0 ? PACK_STEP(ST[nt], 0) : PACK_STEP(ST[nt], 1);
                        y = MFMA32(cat4(lo, hi), sb, y);
                    }
#pragma unroll
                for (int i = 0; i < 16; ++i) y[i] *= fexp(ACS[hw * 32 + crow(i, hh)]);
#pragma unroll
                for (int s = 0; s < 2; ++s) {
                    const s16x4 lo = *(const LAS s16x4*)(lds + SS_X0 + xrow + (16 * s + 4 * hh) * 2);
                    const s16x4 hi = *(const LAS s16x4*)(lds + SS_X0 + xrow + (16 * s + 8 + 4 * hh) * 2);
                    y = MFMA32(s == 0 ? ga0 : ga1, cat4(lo, hi), y);
                }
#pragma unroll
                for (int q = 0; q < 4; ++q) {
                    const s16x4 xv = *(const LAS s16x4*)(lds + SS_X0 + xrow + (8 * q + 4 * hh) * 2);
#pragma unroll
                    for (int e = 0; e < 4; ++e) {
                        const int i = 8 * q + 4 * hh + e;
                        LAS unsigned short* zp = (LAS unsigned short*)(lds + SS_ZS + i * ZSS + (hw * 64 + 32 * ph + r) * 2);
                        const float zv = bf2f(*zp);
                        const float yv = (y[4 * q + e] + Dh * bf2f((unsigned short)xv[e])) * siluf_(zv);
                        *zp = (unsigned short)(pk2(yv, 0.f) & 0xffffu);
                    }
                }
                const float dec = fexp(ACS[hw * 32 + 31]);
#pragma unroll
                for (int nt = 0; nt < 4; ++nt) {
#pragma unroll
                    for (int i = 0; i < 16; ++i) ST[nt][i] *= dec;
#pragma unroll
                    for (int s = 0; s < 2; ++s) {
                        const bf16x8 a = *(const LAS bf16x8*)(lds + SS_BT + (32 * nt + r) * BTS + (16 * s + 8 * hh) * 2);
                        const bf16x8 bq = *(const LAS bf16x8*)(lds + SS_X2 + xrow + (16 * s + 8 * hh) * 2);
                        ST[nt] = MFMA32(a, bq, ST[nt]);
                    }
                }
            }
            __syncthreads();
            if (ch + 1 < nch) SSD_STAGE0(ch + 1, tid);
            {
                const int i = tid >> 4, sub = tid & 15;
                u32x4 v[2]; float ss = 0.f;
#pragma unroll
                for (int k = 0; k < 2; ++k) { v[k] = *(const LAS u32x4*)(lds + SS_ZS + i * ZSS + sub * 32 + k * 16);
#pragma unroll
                    for (int e = 0; e < 4; ++e) { const float a = bflo(v[k][e]), c = bfhi(v[k][e]); ss += a * a + c * c; } }
                ss += __shfl_xor(ss, 1); ss += __shfl_xor(ss, 2); ss += __shfl_xor(ss, 4); ss += __shfl_xor(ss, 8);
                if constexpr (DRY) { asm volatile("" :: "v"(ss), "v"(v[0]), "v"(v[1])); }
                else {
                    if (sub == 0) unsafeAtomicAdd(GST + (row_base + t0 + i) * 4 + g, ss);
#pragma unroll
                    for (int k = 0; k < 2; ++k) *(u32x4*)(Zb + (row_base + t0 + i) * 2048 + g * 512 + hf * 256 + sub * 16 + k * 8) = v[k];
                }
            }
        }
        int tide = tid0; asm volatile("" : "+v"(tide));
        const int tid = tide, r = tide & 31, hh = (tide >> 5) & 1, ph = (tide >> 6) & 1;
#pragma unroll
        for (int nt = 0; nt < 4; ++nt)
#pragma unroll
            for (int q = 0; q < 4; ++q) { f32x4 v; v[0] = ST[nt][4 * q]; v[1] = ST[nt][4 * q + 1]; v[2] = ST[nt][4 * q + 2]; v[3] = ST[nt][4 * q + 3];
                *(f32x4*)(so + (size_t)(32 * ph + r) * 128 + 32 * nt + 8 * q + 4 * hh) = v; }
        float* co = P.out + (smp ? OFF_CONV_S : OFF_CONV_P) + (size_t)b * 3 * 3072;
        for (int idx = tid; idx < 3 * 512; idx += 512) { const int rr = idx >> 9, lc = idx & 511;
            if (lc >= 256 && hf) continue;
            const int gc = lc < 256 ? g * 512 + hf * 256 + lc : (lc < 384 ? 2048 + g * 128 + (lc - 256) : 2560 + g * 128 + (lc - 384));
            co[rr * 3072 + gc] = bf2f(XBC[(row_base + L - 3 + rr) * 3072 + gc]); }
    }
#undef SSD_STAGE0
}

constexpr int AT_K = 0, AT_V = 18432, AT_U = 36864, AT_F = 36880;
constexpr float SB_STICK_EPS = 1.17549435e-38f;
constexpr int KS_ = 144;
constexpr int N_ATT_UNITS = 128 + 4096;

template <bool DIAG> __device__ __forceinline__ void sb_softcum(f32x16& p0, f32x16& p1, float& R, const int kbase, const int qpos, const int hh) {
    float run = R;
#pragma unroll
    for (int t = 1; t >= 0; --t) {
#pragma unroll
        for (int g4 = 3; g4 >= 0; --g4) {
            float s4[4], e4[4]; bool ok[4];
#pragma unroll
            for (int e = 0; e < 4; ++e) {
                const float u = t ? p1[4 * g4 + e] : p0[4 * g4 + e];
                ok[e] = !DIAG || (kbase + 32 * t + 8 * g4 + e < qpos);
                const float ex = fexp2(fminf(u, 64.f));
                const float rr = frcp(1.0f + ex);
                s4[e] = ok[e] ? ex : 0.f;
                e4[e] = ok[e] ? rr : 1.f;
            }
            e4[2] *= e4[3]; e4[1] *= e4[2]; e4[0] *= e4[1];
            const auto sw = __builtin_amdgcn_permlane32_swap(__float_as_uint(e4[0]), __float_as_uint(e4[0]), false, false);
            const float lowT = __uint_as_float(sw[0]), highT = __uint_as_float(sw[1]);
            const float off = hh == 0 ? run * highT : run;
            run *= lowT * highT;
#pragma unroll
            for (int e = 0; e < 4; ++e) {
                const float a = s4[e] * e4[e] * off;
                if (t) p1[4 * g4 + e] = a; else p0[4 * g4 + e] = a;
            }
        }
    }
    R = run;
}

template <bool DRY> __device__ __forceinline__ void attn_phase(const Prm& P, LAS unsigned char* lds) {
    int tid_ = threadIdx.x; asm volatile("" : "+v"(tid_)); const int tid = tid_, lane = tid & 63, w = tid >> 6, r = lane & 31, hh = lane >> 5;
    bf16_t* QO = (bf16_t*)(P.ws + R_QO);
    const bf16_t* KP = (const bf16_t*)(P.ws + R_KP); const bf16_t* VP = (const bf16_t*)(P.ws + R_VP);
    const bf16_t* KSN = (const bf16_t*)(P.ws + R_KSN); const bf16_t* VSN = (const bf16_t*)(P.ws + R_VSN);
    const float* CK = P.in[6]; const float* CV = P.in[7];
    unsigned* counter = (unsigned*)(P.ws + WS_CNT) + (DRY ? 16 : 0);
    LAS unsigned* uw = (LAS unsigned*)(lds + AT_U);
    const int lkey = tid >> 3, ld8 = (tid & 7) * 8;
    int slot = 0;
    if (tid == 0) uw[0] = atomicAdd(counter, 1u);
    for (;;) {
        __syncthreads();
        const int unit = (int)uw[slot];
        if (unit >= N_ATT_UNITS) break;
        if (tid == 0) uw[slot ^ 1] = atomicAdd(counter, 1u);
        slot ^= 1;
        const bool smp = unit < 128;
        int b, kvh, qb;
        if (smp) { b = unit >> 2; kvh = unit & 3; qb = 64; }
        else { const int u2 = unit - 128; qb = 31 - (u2 >> 7); b = (u2 & 127) >> 2; kvh = u2 & 3; }
        const int nblk = qb + 1;
        const bool active = smp ? (w < 4) : true;
        const int head = smp ? kvh * 4 + (w & 3) : kvh * 4 + (w >> 1);
        const int qpos = smp ? PAST + r : 64 * qb + 32 * (w & 1) + r;
        const size_t qrow = smp ? (size_t)MP + b * 32 + r : (size_t)b * 2048 + qpos;
        bf16x8 qf[4];
#pragma unroll
        for (int s = 0; s < 4; ++s) qf[s] = *(const bf16x8*)(QO + qrow * 1024 + head * 64 + 16 * s + 8 * hh);
        f32x16 o[2];
#pragma unroll
        for (int d = 0; d < 2; ++d)
#pragma unroll
            for (int i = 0; i < 16; ++i) o[d][i] = 0.f;
        float R = 1.f;
        u32x4 kreg, vreg;
#define ATT_FETCH(kb) do { const int key = 64 * (kb) + lkey; \
            if (smp && (kb) < 64) { const float* kp_ = CK + (((size_t)b * 4096 + key) * 4 + kvh) * 64 + ld8; const float* vp_ = CV + (((size_t)b * 4096 + key) * 4 + kvh) * 64 + ld8; \
                const f32x4 k0 = *(const f32x4*)kp_, k1 = *(const f32x4*)(kp_ + 4), v0 = *(const f32x4*)vp_, v1 = *(const f32x4*)(vp_ + 4); \
                kreg.x = pk2(k0[0], k0[1]); kreg.y = pk2(k0[2], k0[3]); kreg.z = pk2(k1[0], k1[1]); kreg.w = pk2(k1[2], k1[3]); \
                vreg.x = pk2(v0[0], v0[1]); vreg.y = pk2(v0[2], v0[3]); vreg.z = pk2(v1[0], v1[1]); vreg.w = pk2(v1[2], v1[3]); } \
            else if (smp) { kreg = *(const u32x4*)(KSN + ((size_t)b * 32 + (lkey & 31)) * 256 + kvh * 64 + ld8); vreg = *(const u32x4*)(VSN + ((size_t)b * 32 + (lkey & 31)) * 256 + kvh * 64 + ld8); \
                            if (lkey >= 32) { kreg = (u32x4){0u, 0u, 0u, 0u}; vreg = kreg; } } \
            else { kreg = *(const u32x4*)(KP + ((size_t)b * 2048 + key) * 256 + kvh * 64 + ld8); vreg = *(const u32x4*)(VP + ((size_t)b * 2048 + key) * 256 + kvh * 64 + ld8); } } while (0)
#define ATT_STORE(buf) do { *(LAS u32x4*)(lds + AT_K + (buf) * 9216 + lkey * KS_ + ld8 * 2) = kreg; \
            LAS unsigned short* vt_ = (LAS unsigned short*)(lds + AT_V + (buf) * 9216 + ld8 * KS_ + (lkey ^ ((tid & 7) << 3)) * 2); \
            vt_[0 * 72] = (unsigned short)(vreg.x & 0xffffu); vt_[1 * 72] = (unsigned short)(vreg.x >> 16); vt_[2 * 72] = (unsigned short)(vreg.y & 0xffffu); vt_[3 * 72] = (unsigned short)(vreg.y >> 16); \
            vt_[4 * 72] = (unsigned short)(vreg.z & 0xffffu); vt_[5 * 72] = (unsigned short)(vreg.z >> 16); vt_[6 * 72] = (unsigned short)(vreg.w & 0xffffu); vt_[7 * 72] = (unsigned short)(vreg.w >> 16); } while (0)
        LAS unsigned* fl = (LAS unsigned*)(lds + AT_F);
        if (tid < 3) fl[tid] = 0u;
        ATT_FETCH(qb);
        ATT_STORE(0);
        __syncthreads();
        for (int it = 0; it < nblk; ++it) {
            const int kb = qb - it, buf = it & 1;
            if (it + 1 < nblk) ATT_FETCH(kb - 1);
            if (active) {
                const LAS unsigned char* Kb = lds + AT_K + buf * 9216; const LAS unsigned char* Vb = lds + AT_V + buf * 9216;
                f32x16 p0, p1;
#pragma unroll
                for (int i = 0; i < 16; ++i) { p0[i] = 0.f; p1[i] = 0.f; }
#pragma unroll
                for (int s = 0; s < 4; ++s) {
                    const bf16x8 a0 = *(const LAS bf16x8*)(Kb + r * KS_ + (16 * s + 8 * hh) * 2);
                    const bf16x8 a1 = *(const LAS bf16x8*)(Kb + (32 + r) * KS_ + (16 * s + 8 * hh) * 2);
                    p0 = MFMA32(a0, qf[s], p0); p1 = MFMA32(a1, qf[s], p1);
                }
                if (it == 0) sb_softcum<true>(p0, p1, R, 64 * kb + 4 * hh, qpos, hh);
                else sb_softcum<false>(p0, p1, R, 0, 0, hh);
                const bf16x8 pa00 = PACK_STEP(p0, 0), pa01 = PACK_STEP(p0, 1), pa10 = PACK_STEP(p1, 0), pa11 = PACK_STEP(p1, 1);
#pragma unroll
                for (int d = 0; d < 2; ++d) {
                    const LAS unsigned char* vr = Vb + (32 * d + r) * KS_;
                    const int sw = ((4 * d + (r >> 3)) & 7) << 3;
                    o[d] = MFMA32(pa00, cat4(*(const LAS s16x4*)(vr + ((0 + 4 * hh) ^ sw) * 2), *(const LAS s16x4*)(vr + ((8 + 4 * hh) ^ sw) * 2)), o[d]);
                    o[d] = MFMA32(pa01, cat4(*(const LAS s16x4*)(vr + ((16 + 4 * hh) ^ sw) * 2), *(const LAS s16x4*)(vr + ((24 + 4 * hh) ^ sw) * 2)), o[d]);
                    o[d] = MFMA32(pa10, cat4(*(const LAS s16x4*)(vr + ((32 + 4 * hh) ^ sw) * 2), *(const LAS s16x4*)(vr + ((40 + 4 * hh) ^ sw) * 2)), o[d]);
                    o[d] = MFMA32(pa11, cat4(*(const LAS s16x4*)(vr + ((48 + 4 * hh) ^ sw) * 2), *(const LAS s16x4*)(vr + ((56 + 4 * hh) ^ sw) * 2)), o[d]);
                }
            }
            { const int fw = it % 3;
              if (tid == 0) fl[(it + 1) % 3] = 0u;
              if (active && __any(R >= SB_STICK_EPS) && lane == 0) fl[fw] = 1u;
              if (it + 1 < nblk) ATT_STORE(buf ^ 1);
              __syncthreads();
              if (fl[fw] == 0u) break; }
        }
        if (active) {
#pragma unroll
            for (int d = 0; d < 2; ++d)
#pragma unroll
                for (int i = 0; i < 16; ++i) {
                    const int q = crow(i, hh);
                    const size_t orow = smp ? (size_t)MP + b * 32 + q : (size_t)b * 2048 + 64 * qb + 32 * (w & 1) + q;
                    const unsigned short ov = (unsigned short)(pk2(o[d][i], 0.f) & 0xffffu);
                    if constexpr (DRY) { asm volatile("" :: "v"(ov)); } else { QO[orow * 1024 + head * 64 + 32 * d + r] = ov; }
                }
        }
    }
#undef ATT_FETCH
#undef ATT_STORE
}

#define XB_TMO      128
#define XB_XCNT(j)  (256  + 64 * (j))
#define XB_XSUB(j)  (1280 + 64 * (j))
#define XB_XGEN(j)  (2304 + 64 * (j))
#define XB_TOP      3328
#define XB_TOPGEN   3392
#define XCD_BAR_WORDS 3456
#define XB_SPIN_CAP (1u << 18)

__device__ __forceinline__ unsigned xb_ld(unsigned* p)              { return __hip_atomic_load(p, __ATOMIC_RELAXED, __HIP_MEMORY_SCOPE_AGENT); }
__device__ __forceinline__ unsigned xb_add(unsigned* p, unsigned v) { return __hip_atomic_fetch_add(p, v, __ATOMIC_RELAXED, __HIP_MEMORY_SCOPE_AGENT); }
__device__ __forceinline__ unsigned xb_xcc_id() { return (unsigned)__builtin_amdgcn_s_getreg((3 << 11) | 20) & 0xFu; }
#define XB_SPIN(cond, bar) do { unsigned _sp = 0; while (cond) { __builtin_amdgcn_s_sleep(1); \
    if ((++_sp & 255u) == 0u) { if (xb_ld(&(bar)[XB_TMO])) break; if (_sp > XB_SPIN_CAP) { atomicAdd(&(bar)[XB_TMO], 1u); break; } } } } while (0)

struct XcdBarrier {
    unsigned* bar; unsigned x;
    volatile LAS unsigned* st;
};

__device__ __forceinline__ XcdBarrier xcd_barrier_post(unsigned* bar, volatile LAS unsigned* st) {
    XcdBarrier b; b.bar = bar; b.x = xb_xcc_id(); b.st = st;
    if (threadIdx.x == 0) (void)xb_add(&bar[XB_XCNT(b.x)], 1u);
    return b;
}
__device__ __forceinline__ void xcd_barrier_complete(unsigned* bar, unsigned x, unsigned& nloc, unsigned& nx) {
    const unsigned G = gridDim.x * gridDim.y * gridDim.z;
    unsigned sum, cnt, mine, sp = 0u;
    for (;;) {
        sum = 0u; cnt = 0u; mine = 0u;
#pragma unroll
        for (unsigned j = 0; j < 16; ++j) { const unsigned c = xb_ld(&bar[XB_XCNT(j)]); sum += c; cnt += (c > 0u) ? 1u : 0u; mine = (j == x) ? c : mine; }
        if (sum == G) break;
        __builtin_amdgcn_s_sleep(1);
        if ((++sp & 255u) == 0u) { if (xb_ld(&bar[XB_TMO])) break; if (sp > XB_SPIN_CAP) { atomicAdd(&bar[XB_TMO], 1u); break; } }
    }
    nloc = mine > 0u ? mine : 1u; nx = cnt > 0u ? cnt : 1u;
}

__device__ __forceinline__ void xcd_barrier(const XcdBarrier& b) {
    asm volatile("s_waitcnt vmcnt(0)" ::: "memory");
    __syncthreads();
    if (threadIdx.x == 0) {
        unsigned* bar = b.bar;
        __builtin_amdgcn_s_waitcnt(0);
        unsigned nloc = b.st[0], nx = b.st[1];
        if (nloc == 0u) { xcd_barrier_complete(bar, b.x, nloc, nx); b.st[0] = nloc; b.st[1] = nx; }
        const unsigned old = xb_add(&bar[XB_XSUB(b.x)], 1u);
        const unsigned gen = old / nloc;
        if (old + 1u == (gen + 1u) * nloc) {
            __builtin_amdgcn_fence(__ATOMIC_RELEASE, "agent");
            asm volatile("s_waitcnt vmcnt(0)" ::: "memory");
            const unsigned og = xb_add(&bar[XB_TOP], 1u);
            const unsigned tg = og / nx;
            if (og + 1u == (tg + 1u) * nx) xb_add(&bar[XB_TOPGEN], 1u);
            else XB_SPIN(xb_ld(&bar[XB_TOPGEN]) == tg, bar);
            __builtin_amdgcn_fence(__ATOMIC_ACQUIRE, "agent");
            xb_add(&bar[XB_XGEN(b.x)], 1u);
            asm volatile("s_waitcnt vmcnt(0)" ::: "memory");
        } else {
            XB_SPIN(xb_ld(&bar[XB_XGEN(b.x)]) == gen, bar);
            __builtin_amdgcn_fence(__ATOMIC_ACQUIRE, "agent");
            asm volatile("s_waitcnt vmcnt(0)" ::: "memory");
        }
    }
    __syncthreads();
}


constexpr int NPHASE = 18;
__global__ void __launch_bounds__(512, 2) mega_fwd(Prm P) {
    extern __shared__ __attribute__((aligned(16))) unsigned char lds_raw[];
    LAS unsigned char* lds = (LAS unsigned char*)lds_raw;
    cg::grid_group grid = cg::this_grid();
    const int G = gridDim.x, c = blockIdx.x;
    const bool TAILPROJ_ALL = (G == 256);
    volatile LAS unsigned* bst = (volatile LAS unsigned*)(lds + LDS_BYTES - 256);
    if (threadIdx.x < 2) bst[threadIdx.x] = 0u;
    __syncthreads();
#define PTRS unsigned char* ws = P.ws; asm volatile("" : "+s"(ws)); float* X = P.out; asm volatile("" : "+s"(X)); \
    float* ST = (float*)(ws + WS_ST); bf16_t* WT = (bf16_t*)(ws + WS_WT); bf16_t* XB = (bf16_t*)(ws + WS_XB); bf16_t* PB = (bf16_t*)(ws + WS_PB); \
    bf16_t* ACT = (bf16_t*)(ws + R_ACT); bf16_t* Zb = (bf16_t*)(ws + R_Z); bf16_t* XBC = (bf16_t*)(ws + R_XBC); bf16_t* QO = (bf16_t*)(ws + R_QO); \
    (void)ST; (void)WT; (void)XB; (void)PB; (void)ACT; (void)Zb; (void)XBC; (void)QO; (void)X;
#define ST_(k) (ST + (size_t)(k) * MA)
#define COMMA ,
#define SEAM(k) do { if ((k) + 1 < P.hi) { volatile LAS unsigned* bst_ = (volatile LAS unsigned*)(lds + LDS_BYTES - 256); \
        if ((k) == 0 || MK_CGSYNC) { grid.sync(); if ((k) == 0) (void)xcd_barrier_post((unsigned*)(P.ws + WS_BAR), bst_); } \
        else { XcdBarrier xb_; xb_.bar = (unsigned*)(P.ws + WS_BAR); xb_.x = xb_xcc_id(); xb_.st = bst_; xcd_barrier(xb_); } } } while (0)
#ifndef PH_MASK
#define PH_MASK 0x3ffff
#endif
#define IN(k) (((PH_MASK >> (k)) & 1) && P.lo <= (k) && (k) < P.hi)
#define GEMM_ON(EpiT, Aptr, Bptr, Nn, Kk, Eobj, Gx, cx) do { pg8::Gemm g_{(const bf16_t*)(Aptr), (const bf16_t*)(Bptr), MA, (Nn), (Kk)}; pg8::StaticOrder S_; S_.init(MA, (Nn), (Gx), (cx)); \
        pg8::gemm_phase<EpiT, pg8::StaticOrder, true, true>(lds, g_, S_, Eobj); } while (0)
#define GEMM(EpiT, Aptr, Bptr, Nn, Kk, Eobj) do { pg8::Gemm g_{(const bf16_t*)(Aptr), (const bf16_t*)(Bptr), MA, (Nn), (Kk)}; pg8::StaticOrder S_; S_.init(MA, (Nn), G, c); \
        pg8::gemm_phase<EpiT, pg8::StaticOrder, true, true>(lds, g_, S_, Eobj); } while (0)

#ifndef REAL2_MASK
#define REAL2_MASK 0
#endif
#define RUNPH(k, ...) do { if ((DRY_MASK >> (k)) & 1) { constexpr bool DRY = true; __VA_ARGS__ } if ((REAL2_MASK >> (k)) & 1) { constexpr bool DRY = false; __VA_ARGS__ } { constexpr bool DRY = false; __VA_ARGS__ } } while (0)
    if (IN(0)) { PTRS RUNPH(0, (void)DRY; p0_prologue<0>(P, lds, (int)blockIdx.x, G);); SEAM(0); }
    if (IN(1)) { PTRS RUNPH(1, pg8::EpiGU<DRY> E{ST_(0), ACT, 0, 0, X, ws}; GEMM(pg8::EpiGU<DRY>, XB, WT + O_GU00, 5632, 1024, E););
                if (G == 256 && c >= 88) p0_prologue<2>(P, lds, c - 88, 168); else if (G != 256) p0_prologue<2>(P, lds, c, G);
                SEAM(1); }
    if (IN(2)) { PTRS RUNPH(2, pg8::EpiRes<0 COMMA DRY> E{P.in[0], P.in[1], X, XB, ST_(1), 0.5f, nullptr, nullptr}; GEMM(pg8::EpiRes<0 COMMA DRY>, ACT, WT + O_D, 1024, 2816, E););
                 if (G == 256 && c >= 16) p0_prologue<1>(P, lds, c - 16, 240); else if (G != 256) p0_prologue<1>(P, lds, c, G);
                 SEAM(2); }
    if (IN(3)) { PTRS RUNPH(3, pg8::EpiIn<DRY> E{ST_(1), Zb, XBC, (float*)(ws + WS_DT)}; GEMM(pg8::EpiIn<DRY>, XB, WT + O_IN, NIN, 1024, E););
                if (G == 256 && c >= 84) p0_prologue<3>(P, lds, c - 84, 172); else if (G != 256) p0_prologue<3>(P, lds, c, G);
                SEAM(3); }
    if (IN(4)) { PTRS RUNPH(4, ssd_phase<DRY>(P, lds);); SEAM(4); }
    if (IN(5)) { PTRS RUNPH(5, pg8::EpiRes<2 COMMA DRY> E{X, X + (size_t)MP * 1024, X, XB, ST_(2), 1.0f, (const float*)(ws + WS_GST), nullptr}; GEMM(pg8::EpiRes<2 COMMA DRY>, Zb, WT + O_OUT, 1024, 2048, E););
                if (G == 256 && c >= 16) p0_prologue<4>(P, lds, c - 16, 240); else if (G != 256) p0_prologue<4>(P, lds, c, G);
                SEAM(5); }
    if (IN(6)) { PTRS RUNPH(6, pg8::EpiGU<DRY> E{ST_(2), ACT, 0, 0, X, ws}; GEMM(pg8::EpiGU<DRY>, XB, WT + O_GU01, 5632, 1024, E);); SEAM(6); }
    if (IN(7)) { PTRS RUNPH(7, pg8::EpiRes<0 COMMA DRY> E{X, X + (size_t)MP * 1024, X, XB, ST_(3), 0.5f, nullptr, nullptr}; GEMM(pg8::EpiRes<0 COMMA DRY>, ACT, WT + O_D + D_STRIDE, 1024, 2816, E););
                 if (TAILPROJ_ALL && c >= 16) { pg8::EpiProj<false> E{QO}; GEMM_ON(pg8::EpiProj<false>, PB, WT + O_PP0, 1024, 256, E, 240, c - 16); }
                 SEAM(7); }
    if (IN(8)) { PTRS
        RUNPH(8, if (!TAILPROJ_ALL) { pg8::EpiProj<DRY> E{QO}; GEMM(pg8::EpiProj<DRY>, PB, WT + O_PP0, 1024, 256, E); }
                 { pg8::EpiRes<1 COMMA DRY> E{X, X + (size_t)MP * 1024, X, QO, ST_(4), 1.0f, ST_(3), QO}; GEMM(pg8::EpiRes<1 COMMA DRY>, XB, WT + O_PG0, 1024, 1024, E); });
        SEAM(8); }
    if (IN(9)) { PTRS RUNPH(9, if (TAILPROJ_ALL) { pg8::EpiGU<DRY> E{ST_(4), ACT, 0, 0, X, ws}; GEMM(pg8::EpiGU<DRY>, QO, WT + O_GU10, 5632, 1024, E); }
                               else { pg8::EpiGU<DRY> E{ST_(4), ACT, 2, 0, X, ws}; GEMM(pg8::EpiGU<DRY>, QO, WT + O_KV, 6144, 1024, E); }); SEAM(9); }
    if (IN(10)) { PTRS RUNPH(10, pg8::EpiRes<0 COMMA DRY> E{X, X + (size_t)MP * 1024, X, XB, ST_(5), 0.5f, nullptr, nullptr}; GEMM(pg8::EpiRes<0 COMMA DRY>, ACT, WT + O_D + 2 * D_STRIDE, 1024, 2816, E););
                  if (TAILPROJ_ALL && c >= 16) { pg8::EpiGU<false> E{ST_(4), ACT, 2, 0, X, ws}; GEMM_ON(pg8::EpiGU<false>, QO, WT + O_KV, 512, 1024, E, 240, c - 16); }
                  SEAM(10); }
    if (IN(11)) { PTRS RUNPH(11, pg8::EpiQ<DRY> E{ST_(5), QO}; GEMM(pg8::EpiQ<DRY>, XB, WT + O_Q, 1024, 1024, E););
                  if (G == 256 && c >= 16) p0_prologue<5>(P, lds, c - 16, 240); else if (G != 256) p0_prologue<5>(P, lds, c, G);
                  SEAM(11); }
    if (IN(12)) { PTRS RUNPH(12, attn_phase<DRY>(P, lds);); SEAM(12); }
    if (IN(13)) { PTRS RUNPH(13, pg8::EpiRes<0 COMMA DRY> E{X, X + (size_t)MP * 1024, X, XB, ST_(6), 1.0f, nullptr, nullptr}; GEMM(pg8::EpiRes<0 COMMA DRY>, QO, WT + O_O, 1024, 1024, E););
                  if (G == 256 && c >= 16) p0_prologue<6>(P, lds, c - 16, 240); else if (G != 256) p0_prologue<6>(P, lds, c, G);
                  SEAM(13); }
    if (IN(14)) { PTRS RUNPH(14, pg8::EpiGU<DRY> E{ST_(6), ACT, 0, 0, X, ws}; GEMM(pg8::EpiGU<DRY>, XB, WT + O_GU11, 5632, 1024, E);); SEAM(14); }
    if (IN(15)) { PTRS RUNPH(15, pg8::EpiRes<0 COMMA DRY> E{X, X + (size_t)MP * 1024, X, XB, ST_(7), 0.5f, nullptr, nullptr}; GEMM(pg8::EpiRes<0 COMMA DRY>, ACT, WT + O_D + 3 * D_STRIDE, 1024, 2816, E););
                 if (TAILPROJ_ALL && c >= 16) { pg8::EpiProj<false> E{QO}; GEMM_ON(pg8::EpiProj<false>, PB + (size_t)MA * 256, WT + O_PP1, 1024, 256, E, 240, c - 16); }
                 SEAM(15); }
    if (IN(16)) { PTRS
        RUNPH(16, if (!TAILPROJ_ALL) { pg8::EpiProj<DRY> E{QO}; GEMM(pg8::EpiProj<DRY>, PB + (size_t)MA * 256, WT + O_PP1, 1024, 256, E); }
                  { pg8::EpiRes<1 COMMA DRY> E{X, X + (size_t)MP * 1024, X, nullptr, ST_(8), 1.0f, ST_(7), QO}; GEMM(pg8::EpiRes<1 COMMA DRY>, XB, WT + O_PG1, 1024, 1024, E); });
        SEAM(16); }
#ifdef EXTRA_SYNCS
    for (int i = 0; i < EXTRA_SYNCS; ++i) grid.sync();
#endif
    if (IN(17)) { PTRS final_norm_phase(P); }
}

extern "C" void kernel_launch(void* const* d_in, const int* in_sizes, int n_in, void* d_out, int out_size, void* d_ws, size_t ws_size, hipStream_t stream) {
    static int grid = 0;
    if (grid == 0) {
        if (n_in != 30 || ws_size < WS_END) { fprintf(stderr, "kernel_launch: unexpected n_in %d / ws_size %zu\n", n_in, ws_size); grid = -1; return; }
        int dev = 0, cus = 0, per_cu = 0;
        hipGetDevice(&dev); hipDeviceGetAttribute(&cus, hipDeviceAttributeMultiprocessorCount, dev);
        if (hipFuncSetAttribute((const void*)mega_fwd, hipFuncAttributeMaxDynamicSharedMemorySize, LDS_BYTES) != hipSuccess) { fprintf(stderr, "kernel_launch: hipFuncSetAttribute failed\n"); grid = -1; return; }
        if (hipOccupancyMaxActiveBlocksPerMultiprocessor(&per_cu, (const void*)mega_fwd, 512, LDS_BYTES) != hipSuccess || per_cu < 1) { fprintf(stderr, "kernel_launch: occupancy query %d\n", per_cu); per_cu = 1; }
        (void)hipGetLastError();
        grid = cus * 1;
    }
    if (grid < 0) return;
    Prm p{};
    for (int i = 0; i < 30; ++i) p.in[i] = (const float*)d_in[i];
    p.out = (float*)d_out; p.ws = (unsigned char*)d_ws;
#if MK_MULTI
    for (int ph = 0; ph < NPHASE; ++ph) { p.lo = ph; p.hi = ph + 1; void* args[] = {&p};
        hipError_t e = hipLaunchCooperativeKernel((const void*)mega_fwd, dim3(grid), dim3(512), args, LDS_BYTES, stream);
        if (e != hipSuccess) { fprintf(stderr, "launch %d failed: %s\n", ph, hipGetErrorString(e)); break; } }
#else
    p.lo = 0; p.hi = NPHASE; void* args[] = {&p};
    hipError_t e = hipLaunchCooperativeKernel((const void*)mega_fwd, dim3(grid), dim3(512), args, LDS_BYTES, stream);
    if (e != hipSuccess) fprintf(stderr, "cooperative launch failed: %s (grid %d)\n", hipGetErrorString(e), grid);
#endif
}
```
